# Optimizing an MI355X kernel written in HIP

```python
import math
import jax, jax.numpy as jnp
from jax import lax
import numpy as np

D_MODEL = 1024
BATCH = 32
SEQ = 256
DEPTH = 2
DEC_BATCH = 2
DEC_SEQ = 4096
PAST_LEN = 512

F32 = jnp.float32
GRID_W = 64
POS_BASE = 10000.0
N_DIR = 2
N_EVEN = (DEPTH + 1) // 2
N_ODD = DEPTH // 2
N_MOD = 6
CHUNK = 64
SHORT_CONV = 3
NORM_EPS = 1e-6

A_HEAD_DIM = 128
A_WIDTH = D_MODEL // 2
A_HEADS = A_WIDTH // A_HEAD_DIM
A_FGATE_LO = 3.0
A_FGATE_HI = 6.0
A_COLS = (A_WIDTH, A_WIDTH, A_WIDTH, A_WIDTH, 2 * N_DIR * A_HEADS)
A_IN = sum(A_COLS)

B_HEAD_DIM = 64
B_WIDTH = D_MODEL // 2
B_HEADS = B_WIDTH // B_HEAD_DIM
B_DECAY_RANK = 64
B_AAA_RANK = 64
B_GATE_RANK = 128
B_DECAY_SCALE = 0.606531
B_W0_LO = -6.5
B_W0_HI = -1.5
B_LN_EPS = 64e-5
B_COLS = (B_WIDTH, B_WIDTH, B_WIDTH, N_DIR * B_DECAY_RANK, B_AAA_RANK, B_GATE_RANK)
B_IN = sum(B_COLS)
EVEN_IN = A_IN + B_IN

C_INNER = 2 * D_MODEL
C_HEAD_DIM = 64
C_HEADS = C_INNER // C_HEAD_DIM
C_GROUPS = 8
C_STATE = 128
C_BC = C_GROUPS * C_STATE
C_XBC = C_INNER + 2 * C_BC
ODD_COLS = (C_INNER, C_XBC, N_DIR * C_HEADS)
ODD_IN = sum(ODD_COLS)

FFN_HIDDEN = ((8 * D_MODEL + 3 * 256 - 1) // (3 * 256)) * 256

kernel_name = 'bidir_mlstm_rwkv7_ssd_flow_step'


def split_last(x, sizes):
    return jnp.split(x, np.cumsum(sizes)[:-1].tolist(), axis=-1)


def rev(z, axis, backward):
    return jnp.flip(z, axis) if backward else z


def rms_norm(x, w):
    xf = x.astype(F32)
    y = xf * lax.rsqrt(jnp.mean(xf * xf, -1, keepdims=True) + NORM_EPS) * w.astype(F32)
    return y.astype(x.dtype)


def head_norm(x, w, b, eps):
    xf = x.astype(F32)
    xc = xf - jnp.mean(xf, -1, keepdims=True)
    y = xc * lax.rsqrt(jnp.mean(xc * xc, -1, keepdims=True) + eps) * w.astype(F32)
    return y if b is None else y + b.astype(F32)


def centred_dwconv(x, w, b):
    pad = w.shape[0] // 2
    y = lax.conv_general_dilated(x, w[:, None, :].astype(x.dtype), window_strides=(1,), padding=[(pad, pad)],
                                 dimension_numbers=('NWC', 'WIO', 'NWC'), feature_group_count=x.shape[-1])
    return y + b


def centred_shift(p, mu):
    prev = jnp.pad(p, ((0, 0), (1, 0), (0, 0)))[:, :-1]
    nxt = jnp.pad(p, ((0, 0), (0, 1), (0, 0)))[:, 1:]
    return p + mu * (0.5 * (prev + nxt) - p)


def to_heads(z, nh):
    b, t, w = z.shape
    return z.reshape(b, t, nh, w // nh).transpose(0, 2, 1, 3)


def grid_pos_embed(rows, dim):
    r = jnp.repeat(jnp.arange(rows, dtype=F32), GRID_W)
    col = jnp.tile(jnp.arange(GRID_W, dtype=F32), rows)
    nf = dim // 4
    freq = jnp.exp(-math.log(POS_BASE) * jnp.arange(nf, dtype=F32) / nf)
    ar, ac = r[:, None] * freq, col[:, None] * freq
    return jnp.concatenate([jnp.sin(ar), jnp.cos(ar), jnp.sin(ac), jnp.cos(ac)], -1)


def modulation(cvec, w, b):
    m = jax.nn.silu(cvec) @ w + b
    return [z[:, None, :] for z in jnp.split(m, N_MOD, axis=-1)]


def swiglu(h, w_in, w_out):
    gate, up = jnp.split(h @ w_in, 2, axis=-1)
    return (jax.nn.silu(gate) * up) @ w_out


def mlstm_chunkwise(q, k, v, log_i, log_f, c0, n0, m0):
    bsz, nh, t, dh = q.shape
    nc = t // CHUNK
    qc, kc, vc = (z.reshape(bsz, nh, nc, CHUNK, dh) for z in (q, k, v))
    li = log_i.reshape(bsz, nh, nc, CHUNK)
    b = jnp.cumsum(log_f.reshape(bsz, nh, nc, CHUNK), axis=-1)
    b_end = b[..., -1]
    e = b_end[..., None] - b + li
    m_loc = jnp.max(e, -1)
    w_loc = jnp.exp(e - m_loc[..., None])
    c_loc = jnp.einsum('bhcs,bhcsk,bhcsv->bhckv', w_loc, kc, vc)
    n_loc = jnp.einsum('bhcs,bhcsk->bhck', w_loc, kc)

    def step(carry, inp):
        c, n, m = carry
        be, ml, cl, nl = inp
        m_new = jnp.maximum(be + m, ml)
        dec, sc = jnp.exp(be + m - m_new), jnp.exp(ml - m_new)
        c_new = dec[..., None, None] * c + sc[..., None, None] * cl
        n_new = dec[..., None] * n + sc[..., None] * nl
        return (c_new, n_new, m_new), (c, n, m)

    xs = tuple(jnp.moveaxis(z, 2, 0) for z in (b_end, m_loc, c_loc, n_loc))
    (cf, nf, mf), (cs, ns, ms) = lax.scan(step, (c0, n0, m0), xs)
    cs, ns, ms = jnp.moveaxis(cs, 0, 2), jnp.moveaxis(ns, 0, 2), jnp.moveaxis(ms, 0, 2)
    g = b + ms[..., None]
    causal = jnp.tril(jnp.ones((CHUNK, CHUNK), bool))
    d = jnp.where(causal, b[..., :, None] - b[..., None, :] + li[..., None, :], -jnp.inf)
    m_out = jnp.maximum(g, jnp.max(d, -1))
    w_intra = jnp.exp(d - m_out[..., None])
    w_inter = jnp.exp(g - m_out)
    s = jnp.einsum('bhctk,bhcsk->bhcts', qc, kc) * w_intra
    num = jnp.einsum('bhcts,bhcsv->bhctv', s, vc) + w_inter[..., None] * jnp.einsum('bhctk,bhckv->bhctv', qc, cs)
    den = jnp.sum(s, -1) + w_inter * jnp.einsum('bhctk,bhck->bhct', qc, ns)
    h = num / jnp.maximum(jnp.abs(den), jnp.exp(-m_out))[..., None]
    return h.reshape(bsz, nh, t, dh), (cf, nf, mf)


def rwkv7_scan(r, decay, k, v, kk, a, s0):
    def step(s, inp):
        r_t, w_t, k_t, v_t, kk_t, a_t = inp
        s_kk = jnp.einsum('bhvk,bhk->bhv', s, kk_t)
        s = (s * w_t[:, :, None, :] - s_kk[..., :, None] * (kk_t * a_t)[:, :, None, :]
             + v_t[..., :, None] * k_t[:, :, None, :])
        return s, jnp.einsum('bhvk,bhk->bhv', s, r_t)

    xs = tuple(jnp.moveaxis(z, 1, 0) for z in (r, decay, k, v, kk, a))
    s_final, y = lax.scan(step, s0, xs)
    return jnp.moveaxis(y, 0, 1), s_final


def ssd_chunkwise(x, dt, a, bm, cm, s0):
    bsz, t, nh, hp = x.shape
    ng, nst = bm.shape[2], bm.shape[3]
    hr = nh // ng
    nc = t // CHUNK
    xc = x.reshape(bsz, nc, CHUNK, ng, hr, hp)
    dtc = dt.reshape(bsz, nc, CHUNK, ng, hr)
    bc = bm.reshape(bsz, nc, CHUNK, ng, nst)
    cc = cm.reshape(bsz, nc, CHUNK, ng, nst)
    cum = jnp.cumsum(dtc * a.reshape(ng, hr), axis=2)
    causal = jnp.tril(jnp.ones((CHUNK, CHUNK), bool))[:, :, None, None]
    seg = jnp.exp(jnp.where(causal, cum[:, :, :, None] - cum[:, :, None, :], -jnp.inf))
    dx = dtc[..., None] * xc
    cb = jnp.einsum('bctgn,bcsgn->bctsg', cc, bc)
    y_diag = jnp.einsum('bctsg,bctsgr,bcsgrp->bctgrp', cb, seg, dx)
    decay_end = jnp.exp(cum[:, :, -1:] - cum)
    s_loc = jnp.einsum('bclgn,bclgr,bclgrp->bcgrpn', bc, decay_end, dx)
    chunk_decay = jnp.exp(cum[:, :, -1])

    def step(s, inp):
        cd, sl = inp
        return cd[..., None, None] * s + sl, s

    s_fin, s_start = lax.scan(step, s0.reshape(bsz, ng, hr, hp, nst),
                              (jnp.moveaxis(chunk_decay, 1, 0), jnp.moveaxis(s_loc, 1, 0)))
    s_start = jnp.moveaxis(s_start, 0, 1)
    y_off = jnp.einsum('bctgn,bcgrpn,bctgr->bctgrp', cc, s_start, jnp.exp(cum))
    y = (y_diag + y_off).reshape(bsz, t, nh, hp)
    return y, s_fin.reshape(bsz, nh, hp, nst)


def even_mixer(h, init_state, w_in, a_conv_w, a_conv_b, a_gate_b, a_norm_w,
               b_mu, b_w0, b_w_up, b_a0, b_a_up, b_g_up, b_k_k, b_k_a, b_u, b_ln_w, b_ln_b, w_out):
    c0, n0, m0, s0 = init_state
    bsz, t, _ = h.shape
    proj = h @ w_in
    pa, pb = proj[..., :A_IN], proj[..., A_IN:]
    aq, ak, av, ao, agate = split_last(pa, A_COLS)
    qk = jax.nn.silu(centred_dwconv(jnp.concatenate([aq, ak], -1), a_conv_w, a_conv_b))
    aq, ak = jnp.split(qk.astype(F32), 2, axis=-1)
    q = to_heads(aq, A_HEADS)
    k = to_heads(ak, A_HEADS) * (A_HEAD_DIM ** -0.5)
    v = to_heads(av.astype(F32), A_HEADS)
    gates = (agate.reshape(bsz, t, 2, N_DIR, A_HEADS) + a_gate_b).astype(F32)
    log_i = jnp.moveaxis(gates[:, :, 0], 1, -1)
    log_f = jax.nn.log_sigmoid(jnp.moveaxis(gates[:, :, 1], 1, -1))
    ha = jnp.zeros_like(q)
    st_a = []
    for d in range(N_DIR):
        bw = d == 1
        hd, st = mlstm_chunkwise(rev(q, 2, bw), rev(k, 2, bw), rev(v, 2, bw), rev(log_i[:, d], 2, bw),
                                 rev(log_f[:, d], 2, bw), c0[:, d], n0[:, d], m0[:, d])
        ha = ha + rev(hd, 2, bw)
        st_a.append(st)
    ha = head_norm(ha, a_norm_w.reshape(A_HEADS, 1, A_HEAD_DIM), None, NORM_EPS)
    ya = ha.transpose(0, 2, 1, 3).reshape(bsz, t, A_WIDTH).astype(h.dtype) * jax.nn.sigmoid(ao)
    pb = centred_shift(pb, b_mu).astype(F32)
    br, bk, bv, bw_lo, ba_lo, bg_lo = split_last(pb, B_COLS)
    a = jax.nn.sigmoid(b_a0.astype(F32) + ba_lo @ b_a_up.astype(F32))
    g = jax.nn.sigmoid(bg_lo) @ b_g_up.astype(F32)
    kk = (bk * b_k_k).reshape(bsz, t, B_HEADS, B_HEAD_DIM)
    kk = kk / jnp.maximum(jnp.sqrt(jnp.sum(kk * kk, -1, keepdims=True)), 1e-12)
    kb = bk * (1.0 + (a - 1.0) * b_k_a)
    shp = (bsz, t, B_HEADS, B_HEAD_DIM)
    r, kb, vb, ah = br.reshape(shp), kb.reshape(shp), bv.reshape(shp), a.reshape(shp)
    yb = jnp.zeros_like(r)
    bonus = jnp.zeros_like(r)
    st_b = []
    for d, w_lo in enumerate(jnp.split(bw_lo, N_DIR, axis=-1)):
        bw = d == 1
        decay = jnp.exp(-B_DECAY_SCALE * jax.nn.sigmoid(b_w0[d] + jnp.tanh(w_lo) @ b_w_up[d].astype(F32))).reshape(shp)
        yd, sd = rwkv7_scan(*(rev(z, 1, bw) for z in (r, decay, kb, vb, kk, ah)), s0[:, d])
        yb = yb + rev(yd, 1, bw)
        bonus = bonus + jnp.sum(r * kb * b_u[d].reshape(B_HEADS, B_HEAD_DIM), -1, keepdims=True) * vb
        st_b.append(sd)
    yb = head_norm(yb, b_ln_w.reshape(B_HEADS, B_HEAD_DIM), b_ln_b.reshape(B_HEADS, B_HEAD_DIM), B_LN_EPS) + bonus
    yb = (yb.reshape(bsz, t, B_WIDTH) * g).astype(h.dtype)
    out = jnp.concatenate([ya, yb], axis=-1) @ w_out
    new_state = (jnp.stack([s[0] for s in st_a], 1), jnp.stack([s[1] for s in st_a], 1),
                 jnp.stack([s[2] for s in st_a], 1), jnp.stack(st_b, 1))
    return out, new_state


def odd_mixer(h, s0, w_in, conv_w, conv_b, dt_bias, a_log, d_skip, norm_w, w_out):
    bsz, t, _ = h.shape
    z, xbc, dt_raw = split_last(h @ w_in, ODD_COLS)
    xbc = jax.nn.silu(centred_dwconv(xbc, conv_w, conv_b)).astype(F32)
    xs, bm, cm = split_last(xbc, (C_INNER, C_BC, C_BC))
    xs = xs.reshape(bsz, t, C_HEADS, C_HEAD_DIM)
    bm = bm.reshape(bsz, t, C_GROUPS, C_STATE)
    cm = cm.reshape(bsz, t, C_GROUPS, C_STATE)
    dt_raw = dt_raw.reshape(bsz, t, N_DIR, C_HEADS).astype(F32)
    y = xs * d_skip.astype(F32)[:, None]
    st = []
    for d in range(N_DIR):
        bw = d == 1
        dt = jax.nn.softplus(dt_raw[:, :, d] + dt_bias[d].astype(F32))
        a = -jnp.exp(a_log[d].astype(F32))
        yd, sd = ssd_chunkwise(rev(xs, 1, bw), rev(dt, 1, bw), a, rev(bm, 1, bw), rev(cm, 1, bw), s0[:, d])
        y = y + rev(yd, 1, bw)
        st.append(sd)
    y = y.reshape(bsz, t, C_INNER) * jax.nn.silu(z.astype(F32))
    y = rms_norm(y, norm_w).astype(h.dtype)
    return y @ w_out, jnp.stack(st, 1)


def block(x, mods, nw, fw_in, fw_out, mixer, params, init_state):
    sh1, sc1, g1, sh2, sc2, g2 = mods
    h = rms_norm(x, nw[0]) * (1 + sc1) + sh1
    out, state = mixer(h, init_state, *params)
    x = x + g1 * out
    h = rms_norm(x, nw[1]) * (1 + sc2) + sh2
    x = x + g2 * swiglu(h, fw_in, fw_out)
    return x, state


def setup_inputs(seed: int = 0) -> dict:
    key = jax.random.key(seed)
    keys = iter(jax.random.split(key, 64))

    def nrm(shape, scale):
        return scale * jax.random.normal(next(keys), shape, F32)

    def unif(shape, lo, hi):
        return jax.random.uniform(next(keys), shape, F32, lo, hi)

    d = D_MODEL
    gate_b = jnp.stack([nrm((N_EVEN, N_DIR, A_HEADS), 0.1),
                        jnp.linspace(A_FGATE_LO, A_FGATE_HI, A_HEADS, dtype=F32) + nrm((N_EVEN, N_DIR, A_HEADS), 0.1)],
                       axis=1)
    dt0 = jnp.exp(unif((N_ODD, N_DIR, C_HEADS), math.log(1e-3), math.log(1e-1)))
    return {
        'x_prompt': nrm((BATCH, SEQ, d), 1.0),
        'x_sample': nrm((DEC_BATCH, DEC_SEQ, d), 1.0),
        'state_mlstm_c': nrm((DEC_BATCH, N_EVEN, N_DIR, A_HEADS, A_HEAD_DIM, A_HEAD_DIM), 0.3),
        'state_mlstm_n': nrm((DEC_BATCH, N_EVEN, N_DIR, A_HEADS, A_HEAD_DIM), 0.3),
        'state_mlstm_m': nrm((DEC_BATCH, N_EVEN, N_DIR, A_HEADS), 1.0),
        'state_rwkv': nrm((DEC_BATCH, N_EVEN, N_DIR, B_HEADS, B_HEAD_DIM, B_HEAD_DIM), 0.3),
        'state_ssd': nrm((DEC_BATCH, N_ODD, N_DIR, C_HEADS, C_HEAD_DIM, C_STATE), 0.3),
        'c': nrm((DEC_BATCH, d), 1.0),
        'c_ctx': nrm((d,), 1.0),
        'mod_w': nrm((DEPTH, d, N_MOD * d), 0.5 * d ** -0.5),
        'mod_b': nrm((DEPTH, N_MOD * d), 0.02),
        'norm_w': 1.0 + nrm((DEPTH, 2, d), 0.02),
        'ffn_w_in': nrm((DEPTH, d, 2 * FFN_HIDDEN), d ** -0.5),
        'ffn_w_out': nrm((DEPTH, FFN_HIDDEN, d), FFN_HIDDEN ** -0.5),
        'ev_w_in': nrm((N_EVEN, d, EVEN_IN), d ** -0.5),
        'ev_a_conv_w': nrm((N_EVEN, SHORT_CONV, 2 * A_WIDTH), SHORT_CONV ** -0.5),
        'ev_a_conv_b': nrm((N_EVEN, 2 * A_WIDTH), 0.02),
        'ev_a_gate_b': gate_b,
        'ev_a_norm_w': 1.0 + nrm((N_EVEN, A_WIDTH), 0.02),
        'ev_b_mu': unif((N_EVEN, B_IN), 0.0, 1.0),
        'ev_b_w0': jnp.linspace(B_W0_LO, B_W0_HI, B_WIDTH, dtype=F32) + nrm((N_EVEN, N_DIR, B_WIDTH), 0.1),
        'ev_b_w_up': nrm((N_EVEN, N_DIR, B_DECAY_RANK, B_WIDTH), 0.1 * B_DECAY_RANK ** -0.5),
        'ev_b_a0': nrm((N_EVEN, B_WIDTH), 0.1),
        'ev_b_a_up': nrm((N_EVEN, B_AAA_RANK, B_WIDTH), 0.1 * B_AAA_RANK ** -0.5),
        'ev_b_g_up': nrm((N_EVEN, B_GATE_RANK, B_WIDTH), B_GATE_RANK ** -0.5),
        'ev_b_k_k': 0.85 + nrm((N_EVEN, B_WIDTH), 0.02),
        'ev_b_k_a': 1.0 + nrm((N_EVEN, B_WIDTH), 0.02),
        'ev_b_u': nrm((N_EVEN, N_DIR, B_WIDTH), 0.1),
        'ev_b_ln_w': 1.0 + nrm((N_EVEN, B_WIDTH), 0.02),
        'ev_b_ln_b': nrm((N_EVEN, B_WIDTH), 0.02),
        'ev_w_out': nrm((N_EVEN, A_WIDTH + B_WIDTH, d), (A_WIDTH + B_WIDTH) ** -0.5),
        'od_w_in': nrm((N_ODD, d, ODD_IN), d ** -0.5),
        'od_conv_w': nrm((N_ODD, SHORT_CONV, C_XBC), SHORT_CONV ** -0.5),
        'od_conv_b': nrm((N_ODD, C_XBC), 0.02),
        'od_dt_bias': dt0 + jnp.log(-jnp.expm1(-dt0)),
        'od_a_log': jnp.log(unif((N_ODD, N_DIR, C_HEADS), 1.0, 16.0)),
        'od_d': 1.0 + nrm((N_ODD, C_HEADS), 0.1),
        'od_norm_w': 1.0 + nrm((N_ODD, C_INNER), 0.02),
        'od_w_out': nrm((N_ODD, C_INNER, d), C_INNER ** -0.5),
        'final_norm_w': 1.0 + nrm((d,), 0.02),
    }


def reference(x_prompt, x_sample, state_mlstm_c, state_mlstm_n, state_mlstm_m, state_rwkv, state_ssd,
              c, c_ctx, mod_w, mod_b, norm_w, ffn_w_in, ffn_w_out,
              ev_w_in, ev_a_conv_w, ev_a_conv_b, ev_a_gate_b, ev_a_norm_w,
              ev_b_mu, ev_b_w0, ev_b_w_up, ev_b_a0, ev_b_a_up, ev_b_g_up, ev_b_k_k, ev_b_k_a, ev_b_u,
              ev_b_ln_w, ev_b_ln_b, ev_w_out,
              od_w_in, od_conv_w, od_conv_b, od_dt_bias, od_a_log, od_d, od_norm_w, od_w_out,
              final_norm_w):
    out_dtype = x_prompt.dtype
    rows = x_sample.shape[1] // GRID_W
    xs = x_sample + grid_pos_embed(rows, D_MODEL).astype(x_sample.dtype)
    xp = x_prompt
    bp = x_prompt.shape[0]
    zero_even = (jnp.zeros((bp, N_DIR, A_HEADS, A_HEAD_DIM, A_HEAD_DIM), F32),
                 jnp.zeros((bp, N_DIR, A_HEADS, A_HEAD_DIM), F32),
                 jnp.zeros((bp, N_DIR, A_HEADS), F32),
                 jnp.zeros((bp, N_DIR, B_HEADS, B_HEAD_DIM, B_HEAD_DIM), F32))
    zero_odd = jnp.zeros((bp, N_DIR, C_HEADS, C_HEAD_DIM, C_STATE), F32)
    ev_states, od_states = [], []
    for l in range(DEPTH):
        mods_p = modulation(c_ctx[None, :], mod_w[l], mod_b[l])
        mods_s = modulation(c, mod_w[l], mod_b[l])
        if l % 2 == 0:
            e = l // 2
            params = (ev_w_in[e], ev_a_conv_w[e], ev_a_conv_b[e], ev_a_gate_b[e], ev_a_norm_w[e],
                      ev_b_mu[e], ev_b_w0[e], ev_b_w_up[e], ev_b_a0[e], ev_b_a_up[e], ev_b_g_up[e],
                      ev_b_k_k[e], ev_b_k_a[e], ev_b_u[e], ev_b_ln_w[e], ev_b_ln_b[e], ev_w_out[e])
            cached = (state_mlstm_c[:, e].astype(F32), state_mlstm_n[:, e].astype(F32),
                      state_mlstm_m[:, e].astype(F32), state_rwkv[:, e].astype(F32))
            xp, st = block(xp, mods_p, norm_w[l], ffn_w_in[l], ffn_w_out[l], even_mixer, params, zero_even)
            xs, _ = block(xs, mods_s, norm_w[l], ffn_w_in[l], ffn_w_out[l], even_mixer, params, cached)
            ev_states.append(st)
        else:
            o = l // 2
            params = (od_w_in[o], od_conv_w[o], od_conv_b[o], od_dt_bias[o], od_a_log[o], od_d[o],
                      od_norm_w[o], od_w_out[o])
            xp, st = block(xp, mods_p, norm_w[l], ffn_w_in[l], ffn_w_out[l], odd_mixer, params, zero_odd)
            xs, _ = block(xs, mods_s, norm_w[l], ffn_w_in[l], ffn_w_out[l], odd_mixer, params,
                          state_ssd[:, o].astype(F32))
            od_states.append(st)
    y_prompt = rms_norm(xp, final_norm_w)
    y_sample = rms_norm(xs, final_norm_w)
    new_mlstm_c = jnp.stack([s[0] for s in ev_states], 1).astype(out_dtype)
    new_mlstm_n = jnp.stack([s[1] for s in ev_states], 1).astype(out_dtype)
    new_mlstm_m = jnp.stack([s[2] for s in ev_states], 1).astype(out_dtype)
    new_rwkv = jnp.stack([s[3] for s in ev_states], 1).astype(out_dtype)
    new_ssd = jnp.stack(od_states, 1).astype(out_dtype)
    return (y_prompt, y_sample, new_mlstm_c, new_mlstm_n, new_mlstm_m, new_rwkv, new_ssd)
```

```cpp
#include <hip/hip_runtime.h>
#include <stdint.h>

typedef unsigned short bf16_t;
#define DEV __device__ __forceinline__

constexpr int M_ROWS = 16384;
constexpr int FFN_H = 2816;

DEV float bf2f(bf16_t v) { return __uint_as_float(((unsigned)v) << 16); }
DEV bf16_t f2bf(float f) { unsigned u = __float_as_uint(f); return (bf16_t)((u + 0x7fffu + ((u >> 16) & 1u)) >> 16); }
DEV float sigmoidf_(float x) { return __builtin_amdgcn_rcpf(1.f + __expf(-x)); }
DEV float siluf_(float x) { return x * __builtin_amdgcn_rcpf(1.f + __expf(-x)); }
DEV float logsigmoidf_(float x) { return fminf(x, 0.f) - log1pf(__expf(-fabsf(x))); }
DEV float softplusf_(float x) { return fmaxf(x, 0.f) + log1pf(__expf(-fabsf(x))); }
DEV float wave_sum(float v) {
#pragma unroll
    for (int o = 32; o > 0; o >>= 1) v += __shfl_xor(v, o);
    return v;
}
DEV float block_sum_256(float v, float* sm) {
    v = wave_sum(v);
    if ((threadIdx.x & 63) == 0) sm[threadIdx.x >> 6] = v;
    __syncthreads();
    float r = sm[0] + sm[1] + sm[2] + sm[3];
    __syncthreads();
    return r;
}
DEV void seq_info(int sid, int& row0, int& T) {
    if (sid < 32) { row0 = sid * 256; T = 256; } else { row0 = 8192 + (sid - 32) * 4096; T = 4096; }
}
DEV int row_cls(int row) { return row < 8192 ? 0 : 1 + ((row - 8192) >> 12); }
DEV void row_tT(int row, int& t, int& T) {
    if (row < 8192) { t = row & 255; T = 256; } else { t = (row - 8192) & 4095; T = 4096; }
}

constexpr int PLD = 4096;
constexpr int P2LD = 4352;
namespace pg8 {
#define PG8_LAS __attribute__((address_space(3)))
typedef unsigned short bf16_t;
typedef short bf16x8 __attribute__((ext_vector_type(8)));
typedef float f32x4 __attribute__((ext_vector_type(4)));
typedef unsigned u32x4 __attribute__((ext_vector_type(4)));
typedef unsigned u32x2 __attribute__((ext_vector_type(2)));
constexpr int BM = 256, BK = 64, HALF = 128, HTB = HALF * BK * 2  , STAGE_BYTES = 8 * HTB, NXCD = 8, WGM = 8;

__host__ __device__ __forceinline__ int lds_byte(int r, int c) { const int st = (r >> 4) * 2 + (c >> 5), rr = r & 15, cc = c & 31, ob = rr * 64 + cc * 2; return st * 1024 + (ob ^ (((ob >> 9) & 1) << 5)); }
__host__ __device__ __forceinline__ void stage_rc(int b, int& R, int& C) { const int st = b / 1024, sb = b % 1024, swz = sb ^ (((sb >> 9) & 1) << 5); R = (st >> 1) * 16 + swz / 64; C = (st & 1) * 32 + (swz % 64) / 2; }
__host__ __device__ __forceinline__ int perm32(int rho) { const int n = rho >> 4, i = rho & 15; return 8 * (i >> 2) + 4 * n + (i & 3); }

struct Unit { int pm, pn; };
struct Gemm { const bf16_t* A; const bf16_t* Bt; int M, N, K; };

struct StaticOrder {
    int nM, nN, nwg, G, c;
    __host__ __device__ void init(int M, int N, int G_, int c_) { nM = M / BM; nN = N / BM; nwg = nM * nN; G = G_; c = c_; }
    __host__ __device__ bool next(int i, Unit& u) const {
        const long L = (long)i * G + c; if (L >= nwg) return false;
        int wgid = (int)L; { const int q = nwg / NXCD, r = nwg % NXCD, xcd = wgid % NXCD, off = wgid / NXCD; wgid = (xcd < r ? xcd * (q + 1) : r * (q + 1) + (xcd - r) * q) + off; }
        const int nig = WGM * nN, gid = wgid / nig, fm = gid * WGM, gsz = (nM - fm) < WGM ? (nM - fm) : WGM;
        u.pm = fm + ((wgid % nig) % gsz); u.pn = (wgid % nig) / gsz; return true;
    }
    __device__ __forceinline__ void a_ready(const Unit&) const {}
    __device__ __forceinline__ void done(const Unit&) const {}
};

typedef __bf16 pk_bf16x2_t __attribute__((ext_vector_type(2)));
typedef float pk_f32x2_t __attribute__((ext_vector_type(2)));
__device__ __forceinline__ unsigned cvt_pk_bf16(float lo, float hi) { const pk_f32x2_t f = {lo, hi}; const pk_bf16x2_t b = __builtin_convertvector(f, pk_bf16x2_t); return __builtin_bit_cast(unsigned, b); }
DEV float pg_silu(float x) { return x * __builtin_amdgcn_rcpf(1.f + __expf(-x)); }
struct EpiProj {
    static constexpr bool PERM = true, AFTER_DRAIN = false;
    bf16_t* O; int ldo; float* side; int side_lo, side_n; bf16_t* halo;
    __device__ __forceinline__ void operator()(const f32x4 (&acc)[2][2][4][2], const Unit& u, int wr, int wc, int fr, int fq) const {
        const int row0 = u.pm * BM + wr * 64 + fr, col0 = u.pn * BM + wc * 32 + 8 * fq;
#pragma unroll
        for (int ai = 0; ai < 2; ++ai)
#pragma unroll
            for (int m = 0; m < 4; ++m) {
                const size_t row = (size_t)(row0 + ai * HALF + m * 16);
#pragma unroll
                for (int bj = 0; bj < 2; ++bj) {
                    const int col = col0 + bj * HALF;
                    const f32x4 v0 = acc[ai][bj][m][0], v1 = acc[ai][bj][m][1];
                    u32x4 w; w.x = cvt_pk_bf16(v0[0], v0[1]); w.y = cvt_pk_bf16(v0[2], v0[3]); w.z = cvt_pk_bf16(v1[0], v1[1]); w.w = cvt_pk_bf16(v1[2], v1[3]);
                    *(u32x4*)(O + row * ldo + col) = w;
                    if (halo && ((m == 0 && fr == 0) || (m == 3 && fr == 15))) *(u32x4*)(halo + ((row >> 6) * 2 + (m == 3 ? 1 : 0)) * ldo + col) = w;
                    if (side && col >= side_lo && col < side_lo + side_n) { float* sp = side + row * side_n + (col - side_lo); *(f32x4*)sp = v0; *(f32x4*)(sp + 4) = v1; }
                }
            }
    }
};
__device__ __forceinline__ float dpp_prev(float v) { return __builtin_bit_cast(float, __builtin_amdgcn_update_dpp(0, __builtin_bit_cast(int, v), 0x121, 0xF, 0xF, false)); }
__device__ __forceinline__ float dpp_next(float v) { return __builtin_bit_cast(float, __builtin_amdgcn_update_dpp(0, __builtin_bit_cast(int, v), 0x12F, 0xF, 0xF, false)); }
struct EpiProjMix {
    static constexpr bool PERM = true, AFTER_DRAIN = false;
    bf16_t* O; int ldo; float* side; int side_lo, side_n; float* halo2;
    int ca_lo, ca_n; const float* cw; const float* cb; int sb_lo, sb_n; const float* mu;
    PG8_LAS float* ex;
    __device__ __forceinline__ void operator()(const f32x4 (&acc)[2][2][4][2], const Unit& u, int wr, int wc, int fr, int fq) const {
        const int row0 = u.pm * BM + wr * 64 + fr, cl = wc * 32 + 8 * fq;
#pragma unroll
        for (int ai = 0; ai < 2; ++ai)
#pragma unroll
            for (int bj = 0; bj < 2; ++bj) {
                PG8_LAS float* e0 = ex + ((ai * 2 + wr) * 2) * 256 + bj * HALF + cl;
                if (fr == 0)  { *(PG8_LAS f32x4*)e0 = acc[ai][bj][0][0]; *(PG8_LAS f32x4*)(e0 + 4) = acc[ai][bj][0][1]; }
                if (fr == 15) { *(PG8_LAS f32x4*)(e0 + 256) = acc[ai][bj][3][0]; *(PG8_LAS f32x4*)(e0 + 260) = acc[ai][bj][3][1]; }
            }
        if (halo2 && u.pm >= 32) {
            float* hb = halo2 + (size_t)(u.pm - 32) * 4 * 4096 + u.pn * BM + cl;
#pragma unroll
            for (int bj = 0; bj < 2; ++bj) {
                if (wr == 0 && fr < 2)   { float* h = hb + fr * 4096 + bj * HALF; *(f32x4*)h = acc[0][bj][0][0]; *(f32x4*)(h + 4) = acc[0][bj][0][1]; }
                if (wr == 1 && fr >= 14) { float* h = hb + (fr - 12) * 4096 + bj * HALF; *(f32x4*)h = acc[1][bj][3][0]; *(f32x4*)(h + 4) = acc[1][bj][3][1]; }
            }
        }
        asm volatile("s_waitcnt lgkmcnt(0)" ::: "memory");
        __builtin_amdgcn_s_barrier();
#pragma unroll
        for (int ai = 0; ai < 2; ++ai)
#pragma unroll
            for (int bj = 0; bj < 2; ++bj) {
                const int g0 = u.pn * BM + bj * HALF + wc * 32;
                const int c8 = g0 + 8 * fq;
                const int mode = (g0 >= ca_lo && g0 < ca_lo + ca_n) ? 0 : ((g0 + 32 > sb_lo && g0 < sb_lo + sb_n) ? 1 : 2);
                if (mode == 2) {
#pragma unroll
                    for (int m = 0; m < 4; ++m) {
                        const size_t row = (size_t)(row0 + ai * HALF + m * 16);
                        const f32x4 v0 = acc[ai][bj][m][0], v1 = acc[ai][bj][m][1];
                        u32x4 w; w.x = cvt_pk_bf16(v0[0], v0[1]); w.y = cvt_pk_bf16(v0[2], v0[3]); w.z = cvt_pk_bf16(v1[0], v1[1]); w.w = cvt_pk_bf16(v1[2], v1[3]);
                        *(u32x4*)(O + row * ldo + c8) = w;
                        if (side && c8 >= side_lo && c8 < side_lo + side_n) { float* sp = side + row * side_n + (c8 - side_lo); *(f32x4*)sp = v0; *(f32x4*)(sp + 4) = v1; }
                    }
                    continue;
                }
                f32x4 te[2], be[2];
                {
                    const int ia = wr == 1 ? (ai * 2 + 0) : (ai * 2 - 1), ib = wr == 0 ? (ai * 2 + 1) : (ai * 2 + 2);
                    const PG8_LAS float* pa = ex + ((ia < 0 ? 0 : ia) * 2 + 1) * 256 + bj * HALF + cl;
                    const PG8_LAS float* pb = ex + ((ib > 3 ? 3 : ib) * 2 + 0) * 256 + bj * HALF + cl;
                    te[0] = *(const PG8_LAS f32x4*)pa; te[1] = *(const PG8_LAS f32x4*)(pa + 4); be[0] = *(const PG8_LAS f32x4*)pb; be[1] = *(const PG8_LAS f32x4*)(pb + 4);
                    if (ia < 0) { te[0] = (f32x4){0.f, 0.f, 0.f, 0.f}; te[1] = te[0]; }
                    if (ib > 3) { be[0] = (f32x4){0.f, 0.f, 0.f, 0.f}; be[1] = be[0]; }
                }
                const PG8_LAS float* wp = ex + 2048 + ((const PG8_LAS int*)(ex + 6144))[u.pn] * 1024 + bj * HALF + cl;
                u32x2 ow[4][2];
                const bool f0 = fr == 0, f15 = fr == 15;
                if (mode == 0) {
#pragma unroll
                    for (int n = 0; n < 2; ++n) {
                        const f32x4 w0 = *(const PG8_LAS f32x4*)(wp + 4 * n), w1 = *(const PG8_LAS f32x4*)(wp + 256 + 4 * n), w2 = *(const PG8_LAS f32x4*)(wp + 512 + 4 * n), bb = *(const PG8_LAS f32x4*)(wp + 768 + 4 * n);
                        float o[4][4];
#pragma unroll
                        for (int e = 0; e < 4; ++e) {
                            float rp[4], rn[4];
#pragma unroll
                            for (int m = 0; m < 4; ++m) { rp[m] = dpp_prev(acc[ai][bj][m][n][e]); rn[m] = dpp_next(acc[ai][bj][m][n][e]); }
#pragma unroll
                            for (int m = 0; m < 4; ++m) {
                                const float pv = f0 ? (m == 0 ? te[n][e] : rp[m == 0 ? 0 : m - 1]) : rp[m];
                                const float nv = f15 ? (m == 3 ? be[n][e] : rn[m == 3 ? 3 : m + 1]) : rn[m];
                                const float x = bb[e] + w0[e] * pv + w1[e] * acc[ai][bj][m][n][e] + w2[e] * nv;
                                o[m][e] = x * __builtin_amdgcn_rcpf(1.f + __builtin_amdgcn_exp2f(-1.4426950408889634f * x));
                            }
                        }
#pragma unroll
                        for (int m = 0; m < 4; ++m) { ow[m][n].x = cvt_pk_bf16(o[m][0], o[m][1]); ow[m][n].y = cvt_pk_bf16(o[m][2], o[m][3]); }
                    }
                } else {
#pragma unroll
                    for (int n = 0; n < 2; ++n) {
                        const f32x4 w0 = *(const PG8_LAS f32x4*)(wp + 4 * n);
                        float o[4][4];
#pragma unroll
                        for (int e = 0; e < 4; ++e) {
                            float rp[4], rn[4];
#pragma unroll
                            for (int m = 0; m < 4; ++m) { rp[m] = dpp_prev(acc[ai][bj][m][n][e]); rn[m] = dpp_next(acc[ai][bj][m][n][e]); }
#pragma unroll
                            for (int m = 0; m < 4; ++m) {
                                const float pv = f0 ? (m == 0 ? te[n][e] : rp[m == 0 ? 0 : m - 1]) : rp[m];
                                const float nv = f15 ? (m == 3 ? be[n][e] : rn[m == 3 ? 3 : m + 1]) : rn[m];
                                const float c = acc[ai][bj][m][n][e];
                                o[m][e] = c + w0[e] * (0.5f * (pv + nv) - c);
                            }
                        }
#pragma unroll
                        for (int m = 0; m < 4; ++m) { ow[m][n].x = cvt_pk_bf16(o[m][0], o[m][1]); ow[m][n].y = cvt_pk_bf16(o[m][2], o[m][3]); }
                    }
                }
#pragma unroll
                for (int m = 0; m < 4; ++m) {
                    const size_t row = (size_t)(row0 + ai * HALF + m * 16);
                    u32x4 w; w.x = ow[m][0].x; w.y = ow[m][0].y; w.z = ow[m][1].x; w.w = ow[m][1].y;
                    *(u32x4*)(O + row * ldo + c8) = w;
                    if (side && c8 >= side_lo && c8 < side_lo + side_n) { float* sp = side + row * side_n + (c8 - side_lo); *(f32x4*)sp = acc[ai][bj][m][0]; *(f32x4*)(sp + 4) = acc[ai][bj][m][1]; }
                }
            }
    }
};
__device__ __forceinline__ void store16_wt(void* p, u32x4 v) { asm volatile("global_store_dwordx4 %0, %1, off sc1\n\ts_nop 1" :: "v"(p), "v"(v) : "memory"); }
struct EpiSwiGLU {
    static constexpr bool PERM = true, AFTER_DRAIN = false;
    bf16_t* ACT; int ldo; bool wt;
    __device__ __forceinline__ void operator()(const f32x4 (&acc)[2][2][4][2], const Unit& u, int wr, int wc, int fr, int fq) const {
        const int row0 = u.pm * BM + wr * 64 + fr, col0 = u.pn * HALF + wc * 32 + 8 * fq;
#pragma unroll
        for (int ai = 0; ai < 2; ++ai)
#pragma unroll
            for (int m = 0; m < 4; ++m) {
                const size_t row = (size_t)(row0 + ai * HALF + m * 16);
                float o[8];
#pragma unroll
                for (int n = 0; n < 2; ++n)
#pragma unroll
                    for (int e = 0; e < 4; ++e) o[n * 4 + e] = pg_silu(acc[ai][0][m][n][e]) * acc[ai][1][m][n][e];
                u32x4 w; w.x = cvt_pk_bf16(o[0], o[1]); w.y = cvt_pk_bf16(o[2], o[3]); w.z = cvt_pk_bf16(o[4], o[5]); w.w = cvt_pk_bf16(o[6], o[7]);
                if (wt) store16_wt(ACT + row * ldo + col0, w); else *(u32x4*)(ACT + row * ldo + col0) = w;
            }
    }
};
struct EpiResid {
    static constexpr bool PERM = false, AFTER_DRAIN = false;
    float* X; const float* gate; const float* rowss; float rs_inv_n;
    __device__ __forceinline__ void operator()(const f32x4 (&acc)[2][2][4][2], const Unit& u, int wr, int wc, int fr, int fq) const {
        const int row0 = u.pm * BM + wr * 64 + fr, col0 = u.pn * BM + wc * 32 + 4 * fq;
        const float* g = gate + row_cls(u.pm * BM) * 6144;
        f32x4 gv[2][2];
#pragma unroll
        for (int bj = 0; bj < 2; ++bj)
#pragma unroll
            for (int n = 0; n < 2; ++n) gv[bj][n] = *(const f32x4*)(g + col0 + bj * HALF + n * 16);
#pragma unroll
        for (int ai = 0; ai < 2; ++ai)
#pragma unroll
            for (int m = 0; m < 4; ++m) {
                const size_t row = (size_t)(row0 + ai * HALF + m * 16);
                const float rs = rowss ? rsqrtf(rowss[row] * rs_inv_n + 1e-6f) : 1.f;
                float* xp = X + row * 1024 + col0;
#pragma unroll
                for (int bj = 0; bj < 2; ++bj)
#pragma unroll
                    for (int n = 0; n < 2; ++n) {
                        f32x4 x = *(const f32x4*)(xp + bj * HALF + n * 16);
                        x += gv[bj][n] * (acc[ai][bj][m][n] * rs);
                        *(f32x4*)(xp + bj * HALF + n * 16) = x;
                    }
            }
    }
};
struct EpiResidNorm {
    static constexpr bool PERM = true, AFTER_DRAIN = true;
    bf16_t* XB; float* OUT; const float* gate; const float* rowss; float rs_inv_n;
    float* RS; unsigned* cnt; unsigned* tmo;
    const float* nw; const float* mods; int sh_idx, sc_idx; bf16_t* H;
    unsigned* done;
    __device__ __forceinline__ void operator()(const f32x4 (&)[2][2][4][2], const Unit&, int, int, int, int) const {}
    __device__ __forceinline__ void fused(f32x4 (&acc)[2][2][4][2], const Unit& u, int wr, int wc, int fr, int fq, PG8_LAS unsigned char*, int, int) const {
        const int row0 = u.pm * BM + wr * 64 + fr, col0 = u.pn * BM + wc * 32 + 8 * fq;
        const int cls = row_cls(u.pm * BM);
        {
            const float* g = gate + cls * 6144;
            f32x4 gv[2][2];
#pragma unroll
            for (int bj = 0; bj < 2; ++bj)
#pragma unroll
                for (int n = 0; n < 2; ++n) gv[bj][n] = *(const f32x4*)(g + col0 + bj * HALF + n * 4);
            u32x4 xb[2][2]; float rsb[2];
            const float* rsrc = rowss ? rowss : RS;
#define ERN_LOAD(g_, slot_) do { const size_t row_ = (size_t)(row0 + ((g_) >> 2) * HALF + ((g_) & 3) * 16); const bf16_t* xp_ = XB + row_ * 1024 + col0; \
                _Pragma("unroll") for (int bj_ = 0; bj_ < 2; ++bj_) xb[slot_][bj_] = *(const u32x4*)(xp_ + bj_ * HALF); \
                rsb[slot_] = rsrc[row_]; } while (0)
            ERN_LOAD(0, 0);
#pragma unroll
            for (int g = 0; g < 8; ++g) {
                const int ai = g >> 2, m = g & 3, sl = g & 1;
                if (g < 7) ERN_LOAD(g + 1, sl ^ 1);
                const size_t row = (size_t)(row0 + ai * HALF + m * 16);
                const float rs = rowss ? rsqrtf(rsb[sl] * rs_inv_n + 1e-6f) : 1.f;
                float ss = 0.f;
#pragma unroll
                for (int bj = 0; bj < 2; ++bj)
#pragma unroll
                    for (int n = 0; n < 2; ++n) {
                        const u32x2 xr = n == 0 ? (u32x2){xb[sl][bj].x, xb[sl][bj].y} : (u32x2){xb[sl][bj].z, xb[sl][bj].w};
                        f32x4 x = {__builtin_bit_cast(float, xr.x << 16), __builtin_bit_cast(float, xr.x & 0xffff0000u), __builtin_bit_cast(float, xr.y << 16), __builtin_bit_cast(float, xr.y & 0xffff0000u)};
                        x += gv[bj][n] * (acc[ai][bj][m][n] * rs);
                        acc[ai][bj][m][n] = x;
                        ss += x[0] * x[0] + x[1] * x[1] + x[2] * x[2] + x[3] * x[3];
                    }
                ss += __shfl_xor(ss, 16); ss += __shfl_xor(ss, 32);
                if (fq == 0) atomicAdd(RS + row, ss);
            }
#undef ERN_LOAD
        }
        asm volatile("s_waitcnt vmcnt(0)" ::: "memory");
        __syncthreads();
        if (threadIdx.x == 0) (void)__hip_atomic_fetch_add(cnt + u.pm, 1u, __ATOMIC_RELAXED, __HIP_MEMORY_SCOPE_AGENT);
        if (mods) {
#pragma unroll
            for (int ai = 0; ai < 2; ++ai)
#pragma unroll
                for (int m = 0; m < 4; ++m) {
                    bf16_t* xp = XB + (size_t)(row0 + ai * HALF + m * 16) * 1024 + col0;
#pragma unroll
                    for (int bj = 0; bj < 2; ++bj) { const f32x4 x0 = acc[ai][bj][m][0], x1 = acc[ai][bj][m][1];
                        u32x4 w; w.x = cvt_pk_bf16(x0[0], x0[1]); w.y = cvt_pk_bf16(x0[2], x0[3]); w.z = cvt_pk_bf16(x1[0], x1[1]); w.w = cvt_pk_bf16(x1[2], x1[3]); *(u32x4*)(xp + bj * HALF) = w; }
                }
        }
        f32x4 wv[2][2], sv[2][2];
#pragma unroll
        for (int bj = 0; bj < 2; ++bj)
#pragma unroll
            for (int n = 0; n < 2; ++n) {
                const int c = col0 + bj * HALF + n * 4;
                const float* mb = mods ? mods : nw;
                const f32x4 s1 = *(const f32x4*)(mb + (mods ? cls * 6144 + sc_idx * 1024 : 0) + c), s0 = *(const f32x4*)(mb + (mods ? cls * 6144 + sh_idx * 1024 : 0) + c);
                wv[bj][n] = *(const f32x4*)(nw + c); sv[bj][n] = (f32x4){0.f, 0.f, 0.f, 0.f};
                if (mods) { wv[bj][n] *= (s1 + 1.f); sv[bj][n] = s0; }
            }
        if (threadIdx.x == 0) {
            unsigned* c = cnt + u.pm;
            unsigned sp = 0;
            while (__hip_atomic_load(c, __ATOMIC_RELAXED, __HIP_MEMORY_SCOPE_AGENT) < 4u) {
                __builtin_amdgcn_s_sleep(1);
                if ((++sp & 255u) == 0u) { if (__hip_atomic_load(tmo, __ATOMIC_RELAXED, __HIP_MEMORY_SCOPE_AGENT)) break; if (sp > (1u << 25)) { atomicAdd(tmo, 1u); break; } }
            }
        }
        __syncthreads();
        float rstd[2][4];
#pragma unroll
        for (int ai = 0; ai < 2; ++ai)
#pragma unroll
            for (int m = 0; m < 4; ++m)
                rstd[ai][m] = rsqrtf(__hip_atomic_load(RS + (size_t)(row0 + ai * HALF + m * 16), __ATOMIC_RELAXED, __HIP_MEMORY_SCOPE_AGENT) * (1.f / 1024.f) + 1e-6f);
#pragma unroll
        for (int bj = 0; bj < 2; ++bj) {
            const int c = col0 + bj * HALF;
#pragma unroll
            for (int ai = 0; ai < 2; ++ai)
#pragma unroll
                for (int m = 0; m < 4; ++m) {
                    const f32x4 o0 = acc[ai][bj][m][0] * rstd[ai][m] * wv[bj][0] + sv[bj][0], o1 = acc[ai][bj][m][1] * rstd[ai][m] * wv[bj][1] + sv[bj][1];
                    const size_t off = (size_t)(row0 + ai * HALF + m * 16) * 1024 + c;
                    if (mods) { u32x4 w; w.x = cvt_pk_bf16(o0[0], o0[1]); w.y = cvt_pk_bf16(o0[2], o0[3]); w.z = cvt_pk_bf16(o1[0], o1[1]); w.w = cvt_pk_bf16(o1[2], o1[3]); if (done) store16_wt(H + off, w); else *(u32x4*)(H + off) = w; }
                    else { *(f32x4*)(OUT + off) = o0; *(f32x4*)(OUT + off + 4) = o1; }
                }
        }
        if (done) {
            asm volatile("s_waitcnt vmcnt(0)" ::: "memory");
            __syncthreads();
            if (threadIdx.x == 0) (void)__hip_atomic_fetch_add(done + u.pm, 1u, __ATOMIC_RELAXED, __HIP_MEMORY_SCOPE_AGENT);
        }
        if (!mods && threadIdx.x == 0 && __hip_atomic_load(tmo, __ATOMIC_RELAXED, __HIP_MEMORY_SCOPE_AGENT) != 0u) OUT[(size_t)(u.pm * BM) * 1024 + u.pn * BM] = __builtin_nanf("");
    }
};
struct EpiGateZ {
    static constexpr bool PERM = true, AFTER_DRAIN = false;
    const bf16_t* YS; bf16_t* Y2; int ld; float* rowss;
    const bf16_t* YS2;
    __device__ __forceinline__ void operator()(const f32x4 (&acc)[2][2][4][2], const Unit& u, int wr, int wc, int fr, int fq) const {
        const int row0 = u.pm * BM + wr * 64 + fr, col0 = u.pn * BM + wc * 32 + 8 * fq;
        u32x4 yb[2][2], yc[2][2];
        const bool latt = u.pm >= 32; const float latw = latt ? 1.f : 0.f;
#define EGZ_LOAD(g_, slot_) do { const size_t row_ = (size_t)(row0 + ((g_) >> 2) * HALF + ((g_) & 3) * 16); \
            _Pragma("unroll") for (int bj_ = 0; bj_ < 2; ++bj_) { const int cgl_ = col0 + bj_ * HALF; \
                const size_t sl_ = (size_t)(((cgl_ >> 5) & 1) * 32 + (cgl_ >> 6)); const bf16_t* p1_ = YS + (sl_ * 16384 + row_) * 32 + (cgl_ & 31); \
                yb[slot_][bj_] = *(const u32x4*)p1_; yc[slot_][bj_] = *(const u32x4*)(latt ? YS2 + (sl_ * 8192 + (row_ - 8192)) * 32 + (cgl_ & 31) : p1_); } } while (0)
        EGZ_LOAD(0, 0);
#pragma unroll
        for (int g = 0; g < 8; ++g) {
            const int ai = g >> 2, m = g & 3, sl = g & 1;
            if (g < 7) EGZ_LOAD(g + 1, sl ^ 1);
            const size_t row = (size_t)(row0 + ai * HALF + m * 16);
            float ss = 0.f;
#pragma unroll
            for (int bj = 0; bj < 2; ++bj) {
                const size_t po = row * ld + col0 + bj * HALF;
                const u32x4 y = yb[sl][bj], y2 = yc[sl][bj];
                const unsigned yy[4] = {y.x, y.y, y.z, y.w}, yz[4] = {y2.x, y2.y, y2.z, y2.w};
                float o[8];
#pragma unroll
                for (int e = 0; e < 8; ++e) {
                    const float ys = __uint_as_float((e & 1) ? (yy[e >> 1] & 0xffff0000u) : (yy[e >> 1] << 16)) + latw * __uint_as_float((e & 1) ? (yz[e >> 1] & 0xffff0000u) : (yz[e >> 1] << 16));
                    const float z = acc[ai][bj][m][e >> 2][e & 3];
                    o[e] = ys * pg_silu(z);
                }
                u32x4 w; w.x = cvt_pk_bf16(o[0], o[1]); w.y = cvt_pk_bf16(o[2], o[3]); w.z = cvt_pk_bf16(o[4], o[5]); w.w = cvt_pk_bf16(o[6], o[7]);
                *(u32x4*)(Y2 + po) = w;
#pragma unroll
                for (int e = 0; e < 4; ++e) {
                    const unsigned ww = e == 0 ? w.x : e == 1 ? w.y : e == 2 ? w.z : w.w;
                    const float lo = __uint_as_float(ww << 16), hi = __uint_as_float(ww & 0xffff0000u);
                    ss += lo * lo + hi * hi;
                }
            }
            ss += __shfl_xor(ss, 16); ss += __shfl_xor(ss, 32);
            if (fq == 0) atomicAdd(rowss + row, ss);
        }
#undef EGZ_LOAD
    }
};
template <class Epi, class Sched, bool ALIGN_EPI = false, bool SP2 = false>
__device__ __forceinline__ void gemm_phase(PG8_LAS unsigned char* lds, const Gemm g, const Sched& S, const Epi& E) {
    int tid_l = threadIdx.x; asm volatile("" : "+v"(tid_l));
    const int tid = tid_l, wid = __builtin_amdgcn_readfirstlane(tid >> 6), lane = tid & 63, wr = wid >> 2, wc = wid & 3, fr = lane & 15, fq = lane >> 4;
    const int K = g.K, nt = K / BK;
    unsigned voffA[2], voffB[2];
#pragma unroll
    for (int i = 0; i < 2; ++i) { int R, C; stage_rc(tid * 16 + i * 8192, R, C); const int Rb = Epi::PERM ? ((R & ~31) + perm32(R & 31)) : R;
        voffA[i] = (unsigned)(R * K + C) * 2u; voffB[i] = (unsigned)(Rb * K + C) * 2u; }
    const size_t kstep = (size_t)(BK * 2);
    const size_t hstep = (size_t)HALF * K * 2;
    const size_t tstep = 2 * hstep;
    const unsigned ldsw = (unsigned)wid * 1024u;
    const int aoff = lds_byte(wr * 64 + fr, fq * 8), boff = lds_byte(wc * 32 + fr, fq * 8);
#define PG8_SA(b, h) (((b) * 2 + (h)) * HTB)
#define PG8_SB(b, h) ((4 + (b) * 2 + (h)) * HTB)
#define PG8_STAGE(bufoff, gbase, voff) do { _Pragma("unroll") for (int _i = 0; _i < 2; ++_i) \
        __builtin_amdgcn_global_load_lds((const unsigned*)((const char*)(gbase) + (voff)[_i]), (PG8_LAS unsigned*)(lds + (bufoff) + ldsw + _i * 8192), 16, 0, 0); } while (0)
#define PG8_LDA(dst, b, h) do { _Pragma("unroll") for (int m = 0; m < 4; ++m) _Pragma("unroll") for (int k = 0; k < 2; ++k) dst[m][k] = *(const PG8_LAS bf16x8*)(lds + PG8_SA(b, h) + aoff + m * 2048 + k * 1024); } while (0)
#define PG8_LDB(dst, b, h) do { _Pragma("unroll") for (int n = 0; n < 2; ++n) _Pragma("unroll") for (int k = 0; k < 2; ++k) dst[n][k] = *(const PG8_LAS bf16x8*)(lds + PG8_SB(b, h) + boff + n * 2048 + k * 1024); } while (0)
#define PG8_MMA(ai, bj, At, Bt) do { __builtin_amdgcn_s_setprio(1); _Pragma("unroll") for (int m = 0; m < 4; ++m) _Pragma("unroll") for (int n = 0; n < 2; ++n) _Pragma("unroll") for (int k = 0; k < 2; ++k) \
        acc[ai][bj][m][n] = __builtin_amdgcn_mfma_f32_16x16x32_bf16(Bt[n][k], At[m][k], acc[ai][bj][m][n], 0, 0, 0); __builtin_amdgcn_s_setprio(0); } while (0)
#define PG8_WAIT_V(n) asm volatile("s_waitcnt vmcnt(" #n ")" ::: "memory")
#define PG8_WAIT_L(n) asm volatile("s_waitcnt lgkmcnt(" #n ")" ::: "memory")
#define PG8_BAR __builtin_amdgcn_s_barrier()
#define PG8_SCHED __builtin_amdgcn_sched_barrier(0)
    Unit cur, nxt; int ui = 0;
    if (!S.next(0, cur)) return;
    f32x4 acc[2][2][4][2];
#pragma unroll
    for (int a = 0; a < 2; ++a)
#pragma unroll
        for (int b = 0; b < 2; ++b)
#pragma unroll
            for (int m = 0; m < 4; ++m)
#pragma unroll
                for (int n = 0; n < 2; ++n) acc[a][b][m][n] = (f32x4){0.f, 0.f, 0.f, 0.f};
    bf16x8 At[4][2], B0[2][2], B1[2][2];
    const char* cA = (const char*)g.A + (size_t)cur.pm * tstep; const char* cB = (const char*)g.Bt + (size_t)cur.pn * tstep;
    S.a_ready(cur);
    if constexpr (SP2) {
        PG8_STAGE(PG8_SB(0, 0), cB, voffB); PG8_STAGE(PG8_SB(0, 1), cB + hstep, voffB); PG8_STAGE(PG8_SA(0, 0), cA, voffA); PG8_STAGE(PG8_SA(0, 1), cA + hstep, voffA);
        if (wr == 1) PG8_BAR;
        PG8_WAIT_V(2); PG8_BAR;
        PG8_STAGE(PG8_SB(1, 0), cB + kstep, voffB); PG8_STAGE(PG8_SA(1, 0), cA + kstep, voffA); PG8_STAGE(PG8_SB(1, 1), cB + hstep + kstep, voffB);
        PG8_WAIT_V(6); PG8_BAR;
    } else {
        PG8_STAGE(PG8_SB(0, 0), cB, voffB); PG8_STAGE(PG8_SA(0, 0), cA, voffA); PG8_STAGE(PG8_SB(0, 1), cB + hstep, voffB); PG8_STAGE(PG8_SA(0, 1), cA + hstep, voffA);
        if (wr == 1) PG8_BAR;
        PG8_WAIT_V(4); PG8_BAR;
        PG8_STAGE(PG8_SB(1, 0), cB + kstep, voffB); PG8_STAGE(PG8_SA(1, 0), cA + kstep, voffA); PG8_STAGE(PG8_SB(1, 1), cB + hstep + kstep, voffB);
        PG8_WAIT_V(6); PG8_BAR;
    }
    for (;;) {
        const bool has_next = S.next(ui + 1, nxt);
        const char* nA = has_next ? (const char*)g.A + (size_t)nxt.pm * tstep : cA; const char* nB = has_next ? (const char*)g.Bt + (size_t)nxt.pn * tstep : cB;
        for (int t = 0; t < nt; t += 2) {
            const bool last = (t == nt - 2);
            const char* a1 = cA + (size_t)(t + 1) * kstep;
            const char* a2 = last ? nA : cA + (size_t)(t + 2) * kstep; const char* b2 = last ? nB : cB + (size_t)(t + 2) * kstep;
            const char* a3 = a2 + kstep; const char* b3 = b2 + kstep;
            if (last && has_next) S.a_ready(nxt);
            if constexpr (SP2) {
            PG8_LDB(B0, 0, 0); PG8_LDB(B1, 0, 1); PG8_SCHED; PG8_LDA(At, 0, 0); PG8_STAGE(PG8_SA(1, 1), a1 + hstep, voffA);
            PG8_WAIT_V(8); PG8_WAIT_L(0); PG8_BAR; PG8_MMA(0, 0, At, B0); PG8_MMA(0, 1, At, B1); PG8_BAR; PG8_SCHED;
            PG8_LDA(At, 0, 1); PG8_STAGE(PG8_SB(0, 0), b2, voffB); PG8_STAGE(PG8_SB(0, 1), b2 + hstep, voffB); PG8_STAGE(PG8_SA(0, 0), a2, voffA);
            PG8_WAIT_V(8); PG8_WAIT_L(0); PG8_BAR; PG8_MMA(1, 0, At, B0); PG8_MMA(1, 1, At, B1); PG8_BAR; PG8_SCHED;
            PG8_LDB(B0, 1, 0); PG8_LDB(B1, 1, 1); PG8_SCHED; PG8_LDA(At, 1, 0); PG8_STAGE(PG8_SA(0, 1), a2 + hstep, voffA);
            PG8_WAIT_V(8); PG8_WAIT_L(0); PG8_BAR; PG8_MMA(0, 0, At, B0); PG8_MMA(0, 1, At, B1); PG8_BAR; PG8_SCHED;
            PG8_LDA(At, 1, 1); PG8_STAGE(PG8_SB(1, 0), b3, voffB); PG8_STAGE(PG8_SB(1, 1), b3 + hstep, voffB); PG8_STAGE(PG8_SA(1, 0), a3, voffA);
            PG8_WAIT_V(8); PG8_WAIT_L(0); PG8_BAR; PG8_MMA(1, 0, At, B0); PG8_MMA(1, 1, At, B1); PG8_BAR; PG8_SCHED;
            } else {
            PG8_LDB(B0, 0, 0); PG8_SCHED; PG8_LDA(At, 0, 0); PG8_STAGE(PG8_SA(1, 1), a1 + hstep, voffA);
            PG8_WAIT_L(8); PG8_BAR; PG8_WAIT_L(0); PG8_MMA(0, 0, At, B0); PG8_BAR; PG8_SCHED;
            PG8_LDB(B1, 0, 1); PG8_STAGE(PG8_SB(0, 0), b2, voffB);
            PG8_BAR; PG8_WAIT_L(0); PG8_MMA(0, 1, At, B1); PG8_BAR;
            PG8_LDA(At, 0, 1); PG8_STAGE(PG8_SA(0, 0), a2, voffA);
            PG8_BAR; PG8_WAIT_L(0); PG8_MMA(1, 0, At, B0); PG8_BAR; PG8_SCHED;
            PG8_STAGE(PG8_SB(0, 1), b2 + hstep, voffB);
            PG8_WAIT_V(6); PG8_BAR; PG8_MMA(1, 1, At, B1); PG8_BAR;
            PG8_LDB(B0, 1, 0); PG8_SCHED; PG8_LDA(At, 1, 0); PG8_STAGE(PG8_SA(0, 1), a2 + hstep, voffA);
            PG8_WAIT_L(8); PG8_BAR; PG8_WAIT_L(0); PG8_MMA(0, 0, At, B0); PG8_BAR; PG8_SCHED;
            PG8_LDB(B1, 1, 1); PG8_STAGE(PG8_SB(1, 0), b3, voffB);
            PG8_BAR; PG8_WAIT_L(0); PG8_MMA(0, 1, At, B1); PG8_BAR;
            PG8_LDA(At, 1, 1); PG8_STAGE(PG8_SA(1, 0), a3, voffA);
            PG8_BAR; PG8_WAIT_L(0); PG8_MMA(1, 0, At, B0); PG8_BAR; PG8_SCHED;
            PG8_STAGE(PG8_SB(1, 1), b3 + hstep, voffB);
            PG8_WAIT_V(6); PG8_BAR; PG8_MMA(1, 1, At, B1); PG8_BAR;
            }
        }
        if constexpr (ALIGN_EPI) { if (wr == 0) PG8_BAR; }
        if constexpr (!Epi::AFTER_DRAIN) { E(acc, cur, wr, wc, fr, fq); S.done(cur); }
        if (!has_next) break;
#pragma unroll
        for (int a = 0; a < 2; ++a)
#pragma unroll
            for (int b = 0; b < 2; ++b)
#pragma unroll
                for (int m = 0; m < 4; ++m)
#pragma unroll
                    for (int n = 0; n < 2; ++n) acc[a][b][m][n] = (f32x4){0.f, 0.f, 0.f, 0.f};
        cur = nxt; cA = nA; cB = nB; ++ui;
        if constexpr (ALIGN_EPI) { if (wr == 1) PG8_BAR; }
    }
    PG8_WAIT_V(0);
    if constexpr (!ALIGN_EPI) { if (wr == 0) PG8_BAR; }
    PG8_BAR;
    if constexpr (Epi::AFTER_DRAIN) { E.fused(acc, cur, wr, wc, fr, fq, lds, wid, lane); S.done(cur); }
#undef PG8_SA
#undef PG8_SB
#undef PG8_STAGE
#undef PG8_LDA
#undef PG8_LDB
#undef PG8_MMA
#undef PG8_WAIT_V
#undef PG8_WAIT_L
#undef PG8_BAR
#undef PG8_SCHED
}
}


struct ConvJob { const float* W; const float* kscale; bf16_t* WT; int ldw, K, Ndst, mode, c0, nvalid, item0, nitems; };
constexpr int MAX_CONV = 6;
struct ConvArgs { ConvJob j[MAX_CONV]; int njobs, total, pad0, pad1; };

DEV void conv_item(const ConvJob& J, int item, float* scr, int lane, bool wt = false) {
    const int nblk = J.Ndst / 32, kb = item / nblk, nb = item % nblk, k0 = 64 * kb, n0 = 32 * nb;
    int sc0, nv;
    if (J.mode == 0) { sc0 = J.c0 + n0; nv = J.nvalid - n0; } else { sc0 = ((n0 >> 7) & 1) * 2816 + (n0 >> 8) * 128 + (n0 & 127); nv = 32; }
    const int cc = lane & 31;
    const bool ok = cc < nv;
    const float* src = J.W + (size_t)(k0 + (lane >> 5)) * J.ldw + sc0 + (ok ? cc : 0);
    float v[32];
#pragma unroll
    for (int i = 0; i < 32; ++i) v[i] = src[(size_t)(2 * i) * J.ldw];
    if (J.kscale) {
#pragma unroll
        for (int i = 0; i < 32; ++i) v[i] *= J.kscale[k0 + 2 * i + (lane >> 5)];
    }
#pragma unroll
    for (int i = 0; i < 32; ++i) scr[(2 * i + (lane >> 5)) * 33 + cc] = ok ? v[i] : 0.f;
    asm volatile("s_waitcnt lgkmcnt(0)" ::: "memory");
    const int c = lane & 7;
#pragma unroll
    for (int j = 0; j < 4; ++j) {
        const int n = (lane >> 3) + 8 * j;
        const float* s = scr + (8 * c) * 33 + n;
        uint4 o;
        o.x = pg8::cvt_pk_bf16(s[0 * 33], s[1 * 33]); o.y = pg8::cvt_pk_bf16(s[2 * 33], s[3 * 33]);
        o.z = pg8::cvt_pk_bf16(s[4 * 33], s[5 * 33]); o.w = pg8::cvt_pk_bf16(s[6 * 33], s[7 * 33]);
        if (wt) { pg8::u32x4 ow; ow.x = o.x; ow.y = o.y; ow.z = o.z; ow.w = o.w; pg8::store16_wt(J.WT + (size_t)(n0 + n) * J.K + k0 + 8 * c, ow); }
        else *(uint4*)(J.WT + (size_t)(n0 + n) * J.K + k0 + 8 * c) = o;
    }
    asm volatile("s_waitcnt lgkmcnt(0)" ::: "memory");
}
DEV void conv_all(const ConvArgs& a, float* scr_wave, int gw, int ngw, int lane, bool wt = false) {
    for (int it = gw; it < a.total; it += ngw) {
#pragma unroll
        for (int ji = 0; ji < MAX_CONV; ++ji)
            if (ji < a.njobs && it >= a.j[ji].item0 && it < a.j[ji].item0 + a.j[ji].nitems) conv_item(a.j[ji], it - a.j[ji].item0, scr_wave, lane, wt);
    }
}

DEV uint2 pack4_bf16(float a, float b, float c, float d) { uint2 r; r.x = pg8::cvt_pk_bf16(a, b); r.y = pg8::cvt_pk_bf16(c, d); return r; }

DEV void unpack8(const uint4 raw, float (&f)[8]) {
    f[0] = __uint_as_float(raw.x << 16); f[1] = __uint_as_float(raw.x & 0xffff0000u);
    f[2] = __uint_as_float(raw.y << 16); f[3] = __uint_as_float(raw.y & 0xffff0000u);
    f[4] = __uint_as_float(raw.z << 16); f[5] = __uint_as_float(raw.z & 0xffff0000u);
    f[6] = __uint_as_float(raw.w << 16); f[7] = __uint_as_float(raw.w & 0xffff0000u);
}
DEV uint4 pack8(const float (&f)[8]) {
    uint4 w; w.x = pg8::cvt_pk_bf16(f[0], f[1]); w.y = pg8::cvt_pk_bf16(f[2], f[3]); w.z = pg8::cvt_pk_bf16(f[4], f[5]); w.w = pg8::cvt_pk_bf16(f[6], f[7]); return w;
}


DEV bf16_t* had_slab(bf16_t* A, bf16_t* B, int slab) { return slab < 28 ? A + (size_t)slab * M_ROWS * 32 : B + (size_t)(slab - 28) * M_ROWS * 32; }
DEV const bf16_t* had_slab(const bf16_t* A, const bf16_t* B, int slab) { return slab < 28 ? A + (size_t)slab * M_ROWS * 32 : B + (size_t)(slab - 28) * M_ROWS * 32; }
DEV void phase_embed(const float* xp, const float* xs, float* X, int gw, int ngw, int lane) {
    for (int row = gw; row < M_ROWS; row += ngw) {
        const float* src = row < 8192 ? xp + (size_t)row * 1024 : xs + (size_t)(row - 8192) * 1024;
        const int t = (row - 8192) & 4095;
#pragma unroll
        for (int j = 0; j < 4; ++j) {
            const int c = (lane + 64 * j) * 4;
            float4 v = *(const float4*)(src + c);
            if (row >= 8192) {
                float e[4];
#pragma unroll
                for (int q = 0; q < 4; ++q) {
                    const int cc = c + q, seg = cc >> 8, i = cc & 255;
                    const float freq = expf(-9.210340371976184f * (float)i / 256.f);
                    const float pos = (seg < 2) ? (float)(t >> 6) : (float)(t & 63);
                    const float arg = pos * freq;
                    e[q] = (seg & 1) ? cosf(arg) : sinf(arg);
                }
                v.x += e[0]; v.y += e[1]; v.z += e[2]; v.w += e[3];
            }
            *(float4*)(X + (size_t)row * 1024 + c) = v;
        }
    }
}

DEV void phase_embed_norm(const float* xp, const float* xs, const float* TPOS, bf16_t* XB, const float* nw, const float* mods_l, int sh_idx, int sc_idx, bf16_t* H, int gw, int ngw, int lane) {
    float4 xv[2][4], ev[2][4];
#define EN_LOAD(row_, slot_) do { const int r_ = (row_) < M_ROWS ? (row_) : M_ROWS - 1; const float* src_ = r_ < 8192 ? xp + (size_t)r_ * 1024 : xs + (size_t)(r_ - 8192) * 1024; \
        const int t_ = (r_ - 8192) & 4095; \
        _Pragma("unroll") for (int j_ = 0; j_ < 4; ++j_) { const int c_ = (lane + 64 * j_) * 4, seg_ = c_ >> 8; \
            xv[slot_][j_] = *(const float4*)(src_ + c_); \
            ev[slot_][j_] = *(const float4*)(TPOS + ((seg_ < 2) ? (t_ >> 6) : (t_ & 63)) * 512 + (seg_ & 1) * 256 + (c_ & 255)); } } while (0)
    EN_LOAD(gw, 0);
    int sl = 0;
    for (int row = gw; row < M_ROWS; row += ngw, sl ^= 1) {
        if (sl == 0) EN_LOAD(row + ngw, 1); else EN_LOAD(row + ngw, 0);
        const float lat = row >= 8192 ? 1.f : 0.f;
        float4 v[4]; float ss = 0.f;
#pragma unroll
        for (int j = 0; j < 4; ++j) {
            const int c = (lane + 64 * j) * 4;
            float4 x = sl == 0 ? xv[0][j] : xv[1][j]; const float4 e = sl == 0 ? ev[0][j] : ev[1][j];
            x.x += lat * e.x; x.y += lat * e.y; x.z += lat * e.z; x.w += lat * e.w;
            *(uint2*)(XB + (size_t)row * 1024 + c) = pack4_bf16(x.x, x.y, x.z, x.w);
            v[j] = x; ss += x.x * x.x + x.y * x.y + x.z * x.z + x.w * x.w;
        }
        ss = wave_sum(ss);
        const float rstd = rsqrtf(ss * (1.f / 1024.f) + 1e-6f);
        const int cls = row_cls(row);
        const float* sh = mods_l + cls * 6144 + sh_idx * 1024;
        const float* sc = mods_l + cls * 6144 + sc_idx * 1024;
#pragma unroll
        for (int j = 0; j < 4; ++j) {
            const int c = (lane + 64 * j) * 4;
            const float4 w = *(const float4*)(nw + c), s1 = *(const float4*)(sc + c), s0 = *(const float4*)(sh + c);
            const float o0 = v[j].x * rstd * w.x * (1.f + s1.x) + s0.x, o1 = v[j].y * rstd * w.y * (1.f + s1.y) + s0.y;
            const float o2 = v[j].z * rstd * w.z * (1.f + s1.z) + s0.z, o3 = v[j].w * rstd * w.w * (1.f + s1.w) + s0.w;
            *(uint2*)(H + (size_t)row * 1024 + c) = pack4_bf16(o0, o1, o2, o3);
        }
    }
#undef EN_LOAD
}
DEV void phase_norm(const float* X, const float* nw, const float* mods_l, int sh_idx, int sc_idx, bf16_t* H, int gw, int ngw, int lane) {
    for (int row = gw; row < M_ROWS; row += ngw) {
        const float4* xr = (const float4*)(X + (size_t)row * 1024) + lane;
        float4 v[4]; float ss = 0.f;
#pragma unroll
        for (int j = 0; j < 4; ++j) { v[j] = xr[64 * j]; ss += v[j].x * v[j].x + v[j].y * v[j].y + v[j].z * v[j].z + v[j].w * v[j].w; }
        ss = wave_sum(ss);
        const float rstd = rsqrtf(ss * (1.f / 1024.f) + 1e-6f);
        const int cls = row_cls(row);
        const float* sh = mods_l + cls * 6144 + sh_idx * 1024;
        const float* sc = mods_l + cls * 6144 + sc_idx * 1024;
#pragma unroll
        for (int j = 0; j < 4; ++j) {
            const int c = (lane + 64 * j) * 4;
            const float4 w = *(const float4*)(nw + c), s1 = *(const float4*)(sc + c), s0 = *(const float4*)(sh + c);
            const float o0 = v[j].x * rstd * w.x * (1.f + s1.x) + s0.x, o1 = v[j].y * rstd * w.y * (1.f + s1.y) + s0.y;
            const float o2 = v[j].z * rstd * w.z * (1.f + s1.z) + s0.z, o3 = v[j].w * rstd * w.w * (1.f + s1.w) + s0.w;
            *(uint2*)(H + (size_t)row * 1024 + c) = pack4_bf16(o0, o1, o2, o3);
        }
    }
}
DEV void phase_final_norm(float* X, const float* nw, int gw, int ngw, int lane) {
    for (int row = gw; row < M_ROWS; row += ngw) {
        float4* xr = (float4*)(X + (size_t)row * 1024) + lane;
        float4 v[4]; float ss = 0.f;
#pragma unroll
        for (int j = 0; j < 4; ++j) { v[j] = xr[64 * j]; ss += v[j].x * v[j].x + v[j].y * v[j].y + v[j].z * v[j].z + v[j].w * v[j].w; }
        ss = wave_sum(ss);
        const float rstd = rsqrtf(ss * (1.f / 1024.f) + 1e-6f);
#pragma unroll
        for (int j = 0; j < 4; ++j) {
            const float4 w = *(const float4*)(nw + (lane + 64 * j) * 4);
            xr[64 * j] = make_float4(v[j].x * rstd * w.x, v[j].y * rstd * w.y, v[j].z * rstd * w.z, v[j].w * rstd * w.w);
        }
    }
}

DEV void phase_mods(const float* c, const float* c_ctx, const float* mod_w, const float* mod_b, float* MODS, unsigned char* lds, int tid, int blk, int nblk) {
    float* s = (float*)lds;
    float* red = (float*)(lds + 12288);
    for (int i = tid; i < 3072; i += 512) { const int cls = i >> 10, k = i & 1023; const float v = cls == 0 ? c_ctx[k] : c[(cls - 1) * 1024 + k]; s[i] = siluf_(v); }
    __syncthreads();
    const int col = tid & 15, ks = tid >> 4;
    for (int tile = blk; tile < 768; tile += nblk) {
        const int l = tile / 384, j0 = (tile % 384) * 16;
        const float* W = mod_w + (size_t)l * 1024 * 6144 + j0 + col;
        float a0 = 0.f, a1 = 0.f, a2 = 0.f;
#pragma unroll 8
        for (int k = ks * 32; k < ks * 32 + 32; ++k) { const float w = W[(size_t)k * 6144]; a0 += s[k] * w; a1 += s[1024 + k] * w; a2 += s[2048 + k] * w; }
        red[(ks * 3 + 0) * 16 + col] = a0; red[(ks * 3 + 1) * 16 + col] = a1; red[(ks * 3 + 2) * 16 + col] = a2;
        __syncthreads();
        if (tid < 48) {
            const int cls = tid >> 4;
            float acc = mod_b[l * 6144 + j0 + col];
#pragma unroll
            for (int q = 0; q < 32; ++q) acc += red[(q * 3 + cls) * 16 + col];
            MODS[(l * 3 + cls) * 6144 + j0 + col] = acc;
        }
        __syncthreads();
    }
}

DEV void phase_even_combine(const bf16_t* P, const bf16_t* HAD, const bf16_t* HAD2, const bf16_t* YBD, const float* RK, const float* a_norm_w, const float* mu, const float* g_up,
                            const float* ln_w, const float* ln_b, bf16_t* Y, float* gl, int gw, int ngw, int lane) {
    for (int row = gw; row < M_ROWS; row += ngw) {
        int t, T; row_tT(row, t, T);
        const size_t r = (size_t)row;
#pragma unroll
        for (int q = 0; q < 2; ++q) {
            const int idx = lane + 64 * q, pbcol = 1728 + idx, col = 2064 + pbcol;
            gl[idx] = sigmoidf_(bf2f(P[r * PLD + col]));
        }
        asm volatile("s_waitcnt lgkmcnt(0)" ::: "memory");
        const int c0 = lane * 8;
        {
            float x[8]; float s = 0.f;
            {
                const int hh = c0 >> 7, cc = c0 & 127, vq = cc >> 5, c5 = cc & 31;
                float f0[8], f1[8];
                unpack8(*(const uint4*)(had_slab(HAD, HAD2, (0 * 4 + vq) * 4 + hh) + r * 32 + c5), f0);
                unpack8(*(const uint4*)(had_slab(HAD, HAD2, (1 * 4 + vq) * 4 + hh) + r * 32 + c5), f1);
#pragma unroll
                for (int e = 0; e < 8; ++e) { x[e] = f0[e] + f1[e]; s += x[e]; }
            }
#pragma unroll
            for (int o = 1; o < 16; o <<= 1) s += __shfl_xor(s, o);
            const float mean = s * (1.f / 128.f);
            float q = 0.f;
#pragma unroll
            for (int e = 0; e < 8; ++e) { x[e] -= mean; q += x[e] * x[e]; }
#pragma unroll
            for (int o = 1; o < 16; o <<= 1) q += __shfl_xor(q, o);
            const float rs = rsqrtf(q * (1.f / 128.f) + 1e-6f);
            float y[8];
#pragma unroll
            for (int e = 0; e < 8; ++e) y[e] = x[e] * rs * a_norm_w[c0 + e] * sigmoidf_(bf2f(P[r * PLD + 1536 + c0 + e]));
            uint4 w; w.x = pg8::cvt_pk_bf16(y[0], y[1]); w.y = pg8::cvt_pk_bf16(y[2], y[3]); w.z = pg8::cvt_pk_bf16(y[4], y[5]); w.w = pg8::cvt_pk_bf16(y[6], y[7]);
            *(uint4*)(Y + r * 1024 + c0) = w;
        }
        {
            float x[8]; float s = 0.f;
            const int hd = c0 >> 6, c6 = c0 & 63;
            {
                float f0[8], f1[8];
                unpack8(*(const uint4*)(YBD + ((size_t)(0 * 8 + hd) * M_ROWS + r) * 64 + c6), f0);
                unpack8(*(const uint4*)(YBD + ((size_t)(1 * 8 + hd) * M_ROWS + r) * 64 + c6), f1);
#pragma unroll
                for (int e = 0; e < 8; ++e) { x[e] = f0[e] + f1[e]; s += x[e]; }
            }
#pragma unroll
            for (int o = 1; o < 8; o <<= 1) s += __shfl_xor(s, o);
            const float mean = s * (1.f / 64.f);
            float q = 0.f;
#pragma unroll
            for (int e = 0; e < 8; ++e) { x[e] -= mean; q += x[e] * x[e]; }
#pragma unroll
            for (int o = 1; o < 8; o <<= 1) q += __shfl_xor(q, o);
            const float rs = rsqrtf(q * (1.f / 64.f) + 64e-5f);
            float g[8];
#pragma unroll
            for (int e = 0; e < 8; ++e) g[e] = 0.f;
            for (int i = 0; i < 128; ++i) {
                const float gi = gl[i];
                const float4 u0 = *(const float4*)(g_up + i * 512 + c0), u1 = *(const float4*)(g_up + i * 512 + c0 + 4);
                g[0] += gi * u0.x; g[1] += gi * u0.y; g[2] += gi * u0.z; g[3] += gi * u0.w; g[4] += gi * u1.x; g[5] += gi * u1.y; g[6] += gi * u1.z; g[7] += gi * u1.w;
            }
            float y[8];
            float vb[8]; unpack8(*(const uint4*)(P + r * PLD + 2064 + 1024 + c0), vb);
            const float rk = RK[(size_t)hd * M_ROWS + r];
#pragma unroll
            for (int e = 0; e < 8; ++e) y[e] = (x[e] * rs * ln_w[c0 + e] + ln_b[c0 + e] + rk * vb[e]) * g[e];
            uint4 w; w.x = pg8::cvt_pk_bf16(y[0], y[1]); w.y = pg8::cvt_pk_bf16(y[2], y[3]); w.z = pg8::cvt_pk_bf16(y[4], y[5]); w.w = pg8::cvt_pk_bf16(y[6], y[7]);
            *(uint4*)(Y + r * 1024 + 512 + c0) = w;
        }
        asm volatile("s_waitcnt lgkmcnt(0)" ::: "memory");
    }
}

typedef __attribute__((address_space(3))) bf16_t lbf16;
typedef __attribute__((address_space(3))) float lf32;
typedef short bf16x8_t __attribute__((ext_vector_type(8)));
typedef float f32x4_t __attribute__((ext_vector_type(4)));
typedef unsigned u32x2_t __attribute__((ext_vector_type(2)));
typedef unsigned u32x4_t __attribute__((ext_vector_type(4)));
DEV bf16_t f2bf_fast(float f) { return (bf16_t)(pg8::cvt_pk_bf16(f, 0.f) & 0xffffu); }
template <int K>
DEV f32x4_t mma16(f32x4_t acc, const lbf16* A, int lda, const lbf16* B, int ldb, int lane) {
    const lbf16* ap = A + (lane & 15) * lda + (lane >> 4) * 8;
    const lbf16* bp = B + (lane & 15) * ldb + (lane >> 4) * 8;
    bf16x8_t a[K / 32], b[K / 32];
#pragma unroll
    for (int k = 0; k < K / 32; ++k) { a[k] = *(const __attribute__((address_space(3))) bf16x8_t*)(ap + 32 * k); b[k] = *(const __attribute__((address_space(3))) bf16x8_t*)(bp + 32 * k); }
    __builtin_amdgcn_sched_barrier(0);
#pragma unroll
    for (int k = 0; k < K / 32; ++k) acc = __builtin_amdgcn_mfma_f32_16x16x32_bf16(a[k], b[k], acc, 0, 0, 0);
    return acc;
}
typedef short s16x4_t __attribute__((ext_vector_type(4)));
DEV bf16x8_t frag_tr(const lbf16* src, int S, int k0, int n0, int lane) {
    const int g = lane >> 4, i = lane & 15;
    const lbf16* p = src + (k0 + 8 * g + (i >> 2)) * S + n0 + 4 * (i & 3);
    const s16x4_t lo = __builtin_amdgcn_ds_read_tr16_b64_v4i16((__attribute__((address_space(3))) s16x4_t*)p);
    const s16x4_t hi = __builtin_amdgcn_ds_read_tr16_b64_v4i16((__attribute__((address_space(3))) s16x4_t*)(p + 4 * S));
    bf16x8_t r; r[0] = lo[0]; r[1] = lo[1]; r[2] = lo[2]; r[3] = lo[3]; r[4] = hi[0]; r[5] = hi[1]; r[6] = hi[2]; r[7] = hi[3];
    return r;
}
DEV bf16x8_t frag_row(const lbf16* M, int ld, int k0, int lane) { return *(const __attribute__((address_space(3))) bf16x8_t*)(M + (lane & 15) * ld + (lane >> 4) * 8 + k0); }
template <int K>
DEV f32x4_t mma16_tA(f32x4_t acc, const lbf16* At, int sa, int i0, const lbf16* B, int ldb, int lane) {
    bf16x8_t a[K / 32], b[K / 32];
#pragma unroll
    for (int k = 0; k < K / 32; ++k) { a[k] = frag_tr(At, sa, 32 * k, i0, lane); b[k] = frag_row(B, ldb, 32 * k, lane); }
    __builtin_amdgcn_sched_barrier(0);
#pragma unroll
    for (int k = 0; k < K / 32; ++k) acc = __builtin_amdgcn_mfma_f32_16x16x32_bf16(a[k], b[k], acc, 0, 0, 0);
    return acc;
}
template <int K>
DEV f32x4_t mma16_tB(f32x4_t acc, const lbf16* A, int lda, const lbf16* Bt, int sb, int j0, int lane) {
    bf16x8_t a[K / 32], b[K / 32];
#pragma unroll
    for (int k = 0; k < K / 32; ++k) { a[k] = frag_row(A, lda, 32 * k, lane); b[k] = frag_tr(Bt, sb, 32 * k, j0, lane); }
    __builtin_amdgcn_sched_barrier(0);
#pragma unroll
    for (int k = 0; k < K / 32; ++k) acc = __builtin_amdgcn_mfma_f32_16x16x32_bf16(a[k], b[k], acc, 0, 0, 0);
    return acc;
}
template <int K>
DEV f32x4_t mma16_tAB(f32x4_t acc, const lbf16* At, int sa, int i0, const lbf16* Bt, int sb, int j0, int lane) {
    bf16x8_t a[K / 32], b[K / 32];
#pragma unroll
    for (int k = 0; k < K / 32; ++k) { a[k] = frag_tr(At, sa, 32 * k, i0, lane); b[k] = frag_tr(Bt, sb, 32 * k, j0, lane); }
    __builtin_amdgcn_sched_barrier(0);
#pragma unroll
    for (int k = 0; k < K / 32; ++k) acc = __builtin_amdgcn_mfma_f32_16x16x32_bf16(a[k], b[k], acc, 0, 0, 0);
    return acc;
}
template <int K>
DEV void mma16_2A(f32x4_t& acc0, f32x4_t& acc1, const lbf16* A0, const lbf16* A1, int lda, const lbf16* B, int ldb, int lane) {
    bf16x8_t a0[K / 32], a1[K / 32], b[K / 32];
#pragma unroll
    for (int k = 0; k < K / 32; ++k) { b[k] = frag_row(B, ldb, 32 * k, lane); a0[k] = frag_row(A0, lda, 32 * k, lane); a1[k] = frag_row(A1, lda, 32 * k, lane); }
    __builtin_amdgcn_sched_barrier(0);
#pragma unroll
    for (int k = 0; k < K / 32; ++k) { acc0 = __builtin_amdgcn_mfma_f32_16x16x32_bf16(a0[k], b[k], acc0, 0, 0, 0); acc1 = __builtin_amdgcn_mfma_f32_16x16x32_bf16(a1[k], b[k], acc1, 0, 0, 0); }
}
template <int K>
DEV void mma16_tAB_2B(f32x4_t& acc0, f32x4_t& acc1, const lbf16* At, int sa, int i0, const lbf16* Bt, int sb, int j00, int j01, int lane) {
    bf16x8_t a[K / 32], b0[K / 32], b1[K / 32];
#pragma unroll
    for (int k = 0; k < K / 32; ++k) { a[k] = frag_tr(At, sa, 32 * k, i0, lane); b0[k] = frag_tr(Bt, sb, 32 * k, j00, lane); b1[k] = frag_tr(Bt, sb, 32 * k, j01, lane); }
    __builtin_amdgcn_sched_barrier(0);
#pragma unroll
    for (int k = 0; k < K / 32; ++k) { acc0 = __builtin_amdgcn_mfma_f32_16x16x32_bf16(a[k], b0[k], acc0, 0, 0, 0); acc1 = __builtin_amdgcn_mfma_f32_16x16x32_bf16(a[k], b1[k], acc1, 0, 0, 0); }
}
DEV void st4_bf16(lbf16* dst, f32x4_t v) { u32x2_t w; w.x = pg8::cvt_pk_bf16(v[0], v[1]); w.y = pg8::cvt_pk_bf16(v[2], v[3]); *(__attribute__((address_space(3))) u32x2_t*)dst = w; }
DEV void st16_lds(lbf16* dst, const uint4 v) { u32x4_t w; w.x = v.x; w.y = v.y; w.z = v.z; w.w = v.w; *(__attribute__((address_space(3))) u32x4_t*)dst = w; }
template <int CTRL, int RMASK> DEV float dpp_src(float ident, float v) { return __builtin_bit_cast(float, __builtin_amdgcn_update_dpp(__builtin_bit_cast(int, ident), __builtin_bit_cast(int, v), CTRL, RMASK, 0xF, false)); }
DEV float wave_incl_scan_add(float v, int) {
    v += dpp_src<0x111, 0xF>(0.f, v); v += dpp_src<0x112, 0xF>(0.f, v); v += dpp_src<0x114, 0xF>(0.f, v); v += dpp_src<0x118, 0xF>(0.f, v);
    v += dpp_src<0x142, 0xA>(0.f, v); v += dpp_src<0x143, 0xC>(0.f, v);
    return v;
}
DEV float wave_incl_scan_max(float v, int) {
    const float ninf = -__builtin_inff();
    v = fmaxf(v, dpp_src<0x111, 0xF>(ninf, v)); v = fmaxf(v, dpp_src<0x112, 0xF>(ninf, v)); v = fmaxf(v, dpp_src<0x114, 0xF>(ninf, v)); v = fmaxf(v, dpp_src<0x118, 0xF>(ninf, v));
    v = fmaxf(v, dpp_src<0x142, 0xA>(ninf, v)); v = fmaxf(v, dpp_src<0x143, 0xC>(ninf, v));
    return v;
}
DEV void phase_localmix(bf16_t* P, int ld, int gemm_n, const bf16_t* HALO, int ca_lo, int ca_n, const float* cw, const float* cb, int sb_lo, int sb_n, const float* mu, int tid, int blk, int G) {
    pg8::StaticOrder S; S.init(M_ROWS, gemm_n, G, blk);
    pg8::Unit u;
    const int cg = tid & 31, rg = (tid >> 5) & 7, chh = tid >> 8;
    for (int it = 0; S.next(it, u); ++it) {
        const int col = u.pn * 256 + 8 * cg;
        const int mode = (col >= ca_lo && col < ca_lo + ca_n) ? 0 : ((col >= sb_lo && col < sb_lo + sb_n) ? 1 : 2);
        const bool valid = mode != 2;
        const int chan = mode == 0 ? col - ca_lo : col - sb_lo;
        float wv[3][8], bv[8];
        if (valid) {
#pragma unroll
            for (int e = 0; e < 8; ++e) {
                if (mode == 0) { wv[0][e] = cw[chan + e]; wv[1][e] = cw[ca_n + chan + e]; wv[2][e] = cw[2 * ca_n + chan + e]; bv[e] = cb[chan + e]; }
                else { wv[0][e] = mu[chan + e]; wv[1][e] = 0.f; wv[2][e] = 0.f; bv[e] = 0.f; }
            }
        }
        for (int cp = 0; cp < 2; ++cp) {
            const int c = u.pm * 4 + cp * 2 + chh;
            const bool first = (c < 128) ? ((c & 3) == 0) : (((c - 128) & 63) == 0);
            const bool last = (c < 128) ? ((c & 3) == 3) : (((c - 128) & 63) == 63);
            uint4 raw[10];
            if (valid) {
#pragma unroll
                for (int rr = 0; rr < 10; ++rr) {
                    const int ri = 8 * rg + rr - 1;
                    const bool lo = ri < 0, hi = ri > 63;
                    const int hc = lo ? (c > 0 ? c - 1 : 0) : (c < 255 ? c + 1 : 255);
                    const bf16_t* src = (lo || hi) ? HALO + (size_t)(hc * 2 + (lo ? 1 : 0)) * ld + col : P + (size_t)(64 * c + ri) * ld + col;
                    uint4 v = *(const uint4*)src;
                    if ((lo && first) || (hi && last)) v = make_uint4(0u, 0u, 0u, 0u);
                    raw[rr] = v;
                }
            }
            asm volatile("s_waitcnt vmcnt(0)" ::: "memory");
            __syncthreads();
            if (valid) {
                float prev[8], cur[8], nxt[8];
                unpack8(raw[0], prev); unpack8(raw[1], cur);
#pragma unroll
                for (int rr = 0; rr < 8; ++rr) {
                    unpack8(raw[rr + 2], nxt);
                    float o[8];
#pragma unroll
                    for (int e = 0; e < 8; ++e) {
                        if (mode == 0) o[e] = siluf_(bv[e] + wv[0][e] * prev[e] + wv[1][e] * cur[e] + wv[2][e] * nxt[e]);
                        else o[e] = cur[e] + wv[0][e] * (0.5f * (prev[e] + nxt[e]) - cur[e]);
                    }
                    *(uint4*)(P + (size_t)(64 * c + 8 * rg + rr) * ld + col) = pack8(o);
#pragma unroll
                    for (int e = 0; e < 8; ++e) { prev[e] = cur[e]; cur[e] = nxt[e]; }
                }
            }
        }
    }
}

DEV void phase_mix_edges(bf16_t* P, int ld, const float* H2, int ca_lo, int ca_n, const float* cw, const float* cb, int sb_lo, int sb_n, const float* mu, int tid, int blk, int G) {
    pg8::StaticOrder S; S.init(M_ROWS, 4096, G, blk);
    pg8::Unit u;
    for (int it = 0; S.next(it, u); ++it) {
        const int T = u.pm >= 32 ? u.pm - 32 : 0, j = T & 15, bot = tid >> 8, col = u.pn * 256 + (tid & 255);
        const bool interior = u.pm >= 32 && (bot ? j < 15 : j > 0);
        const int mode = (col >= ca_lo && col < ca_lo + ca_n) ? 0 : ((col >= sb_lo && col < sb_lo + sb_n) ? 1 : 2);
        const int Tp = bot ? T : (T > 0 ? T - 1 : 0), Tn = bot ? (T < 31 ? T + 1 : 31) : T;
        const float pv = H2[((size_t)Tp * 4 + (bot ? 2 : 3)) * 4096 + col];
        const float cv = H2[((size_t)T * 4 + (bot ? 3 : 0)) * 4096 + col];
        const float nv = H2[((size_t)Tn * 4 + (bot ? 0 : 1)) * 4096 + col];
        const int ch = mode == 0 ? col - ca_lo : 0, sh = mode == 1 ? col - sb_lo : 0;
        const float a0 = cw[ch], a1 = cw[ca_n + ch], a2 = cw[2 * ca_n + ch], ab = cb[ch], m0 = mu[sh];
        const float x = ab + a0 * pv + a1 * cv + a2 * nv;
        const float o = mode == 0 ? x * __builtin_amdgcn_rcpf(1.f + __expf(-x)) : cv + m0 * (0.5f * (pv + nv) - cv);
        if (interior && mode != 2) P[(size_t)(u.pm * 256 + (bot ? 255 : 0)) * ld + col] = f2bf(o);
    }
}

DEV void stage_mix_weights(unsigned char* lds_, int gemm_n, int ca_lo, int ca_n, const float* cw, const float* cb, int sb_lo, int sb_n, const float* mu, int tid, int blk, int G) {
    lf32* wl = (lf32*)(lds_ + pg8::STAGE_BYTES) + 2048; __attribute__((address_space(3))) int* sop = (__attribute__((address_space(3))) int*)((lf32*)(lds_ + pg8::STAGE_BYTES) + 6144);
    pg8::StaticOrder S; S.init(M_ROWS, gemm_n, G, blk);
    pg8::Unit u;
    for (int i = 0; i < 4 && S.next(i, u); ++i) {
        if (tid == 0) sop[u.pn] = i;
        for (int cc = tid; cc < 256; cc += 512) {
            const int col = u.pn * 256 + cc;
            const bool conv = col >= ca_lo && col < ca_lo + ca_n, shf = col >= sb_lo && col < sb_lo + sb_n;
            const int ch = conv ? col - ca_lo : 0, sh = shf ? col - sb_lo : 0;
            const float a0 = cw[ch], a1 = cw[ca_n + ch], a2 = cw[2 * ca_n + ch], ab = cb[ch], m0 = mu[sh];
            wl[(i * 4 + 0) * 256 + cc] = conv ? a0 : (shf ? m0 : 0.f); wl[(i * 4 + 1) * 256 + cc] = conv ? a1 : 0.f; wl[(i * 4 + 2) * 256 + cc] = conv ? a2 : 0.f; wl[(i * 4 + 3) * 256 + cc] = conv ? ab : 0.f;
        }
    }
    __syncthreads();
}

DEV void phase_dt(const bf16_t* H, const bf16_t* Wdt, float* DT, unsigned char* lds_, int tid, int blk, int G) {
    lbf16* Wl = (lbf16*)lds_; lf32* Pr = (lf32*)(lds_ + 64 * 1032 * 2);
    const int lane = tid & 63, wave = tid >> 6, l15 = lane & 15, g8 = (lane >> 4) * 8, tr = wave & 3, kh = wave >> 2;
    for (int rt = blk; rt < M_ROWS / 64; rt += G) {
        const bf16_t* hp = H + (size_t)(64 * rt + 16 * tr + l15) * 1024 + 512 * kh + g8;
        bf16x8_t hb[16];
#pragma unroll
        for (int u = 0; u < 16; ++u) hb[u] = *(const bf16x8_t*)(hp + 32 * u);
        uint4 wst[16];
#pragma unroll
        for (int i = 0; i < 16; ++i) { const int idx = tid + 512 * i; wst[i] = *(const uint4*)(Wdt + (size_t)(idx >> 7) * 1024 + (idx & 127) * 8); }
#pragma unroll
        for (int i = 0; i < 16; ++i) { const int idx = tid + 512 * i; st16_lds(Wl + (idx >> 7) * 1032 + (idx & 127) * 8, wst[i]); }
        __syncthreads();
        f32x4_t acc[4];
#pragma unroll
        for (int tc = 0; tc < 4; ++tc) acc[tc] = (f32x4_t){0.f, 0.f, 0.f, 0.f};
#pragma unroll
        for (int u = 0; u < 16; ++u)
#pragma unroll
            for (int tc = 0; tc < 4; ++tc) {
                const bf16x8_t wf = *(const __attribute__((address_space(3))) bf16x8_t*)(Wl + (16 * tc + l15) * 1032 + 512 * kh + 32 * u + g8);
                acc[tc] = __builtin_amdgcn_mfma_f32_16x16x32_bf16(wf, hb[u], acc[tc], 0, 0, 0);
            }
        if (kh == 1) {
#pragma unroll
            for (int tc = 0; tc < 4; ++tc) *(__attribute__((address_space(3))) f32x4_t*)(Pr + ((tr * 4 + tc) * 64 + lane) * 4) = acc[tc];
        }
        __syncthreads();
        if (kh == 0) {
            float* dp = DT + (size_t)(64 * rt + 16 * tr + l15) * 64 + 4 * (lane >> 4);
#pragma unroll
            for (int tc = 0; tc < 4; ++tc) { const f32x4_t p = *(const __attribute__((address_space(3))) f32x4_t*)(Pr + ((tr * 4 + tc) * 64 + lane) * 4); *(f32x4_t*)(dp + 16 * tc) = acc[tc] + p; }
        }
        __syncthreads();
    }
}

constexpr int SS_CM = 0, SS_BM = 17408, SS_XA = 34816, SS_XB = 39936, SS_W = 45056, SS_SBF = 54272, SS_SET = 62976;
constexpr int SS2_XA = 34816, SS2_XB = 44032, SS2_W = 53248, SS2_SBF = 62464, SS2_SET = 79872;
template <int NP>
DEV void job_ssd_chunked(const int sid, const int h, const int ph, unsigned char* lds_, int tid, const bf16_t* XBC, const float* DT, const float* dt_bias, const float* a_log,
                         const float* dskip, const float* s0, bf16_t* YS, float* out_s) {
    constexpr int SET = NP == 1 ? SS_SET : SS2_SET, OXA = NP == 1 ? SS_XA : SS2_XA, OXB = NP == 1 ? SS_XB : SS2_XB, OW = NP == 1 ? SS_W : SS2_W, OSBF = NP == 1 ? SS_SBF : SS2_SBF, XS = NP == 1 ? 40 : 72, CS = NP == 1 ? 4096 : 256;
    lf32* cumT = (lf32*)(lds_ + 2 * SET);
    int row0, T; seq_info(sid, row0, T);
    const int nc = T >> 6, g = h >> 2, lane = tid & 63, wave = tid >> 6, q4 = (lane >> 4) * 4, l15 = lane & 15;
    const int p0 = NP == 1 ? 32 * ph : 0;
    f32x4_t S[2][2 * NP];
    float inv_a[2];
#pragma unroll
    for (int d = 0; d < 2; ++d) {
        inv_a[d] = -__expf(-a_log[d * 32 + h]);
#pragma unroll
        for (int tp = 0; tp < 2 * NP; ++tp) {
            if (sid >= 32) S[d][tp] = *(const f32x4_t*)(s0 + ((size_t)((sid - 32) * 2 + d) * 32 + h) * 8192 + (size_t)(p0 + 16 * tp + l15) * 128 + 16 * wave + q4);
            else S[d][tp] = (f32x4_t){0.f, 0.f, 0.f, 0.f};
        }
    }
    const float dsk = dskip[h];
    {
        const int dd = wave & 1;
        const float bias = dt_bias[dd * 32 + h], a_d = -__expf(a_log[dd * 32 + h]);
        if (nc == 64) {
            float dv[16];
#pragma unroll
            for (int k = 0; k < 16; ++k) { const int step = (wave + 8 * k) >> 1, cidx = dd ? nc - 1 - step : step; dv[k] = DT[(size_t)(row0 + 64 * cidx + (dd ? 63 - lane : lane)) * 64 + dd * 32 + h]; }
#pragma unroll
            for (int k = 0; k < 16; ++k) { const int step = (wave + 8 * k) >> 1; cumT[dd * CS + 64 * step + lane] = wave_incl_scan_add(softplusf_(dv[k] + bias) * a_d, lane); }
        } else {
            for (int item = wave; item < 2 * nc; item += 8) {
                const int step = item >> 1, cidx = dd ? nc - 1 - step : step;
                const size_t row = (size_t)(row0 + 64 * cidx + (dd ? 63 - lane : lane));
                cumT[dd * CS + 64 * step + lane] = wave_incl_scan_add(softplusf_(DT[row * 64 + dd * 32 + h] + bias) * a_d, lane);
            }
        }
    }
    __syncthreads();
    const int o_tt = wave >> 1, o_t = 16 * o_tt + l15;
    for (int step = 0; step < nc; ++step) {
        const bool first = step < (nc >> 1);
        uint4 pc0[2], pb0[2], pc1[2], pb1[2], px[2];
#pragma unroll
        for (int d = 0; d < 2; ++d) {
            const int rbase = row0 + 64 * (d ? nc - 1 - step : step);
            const int j = tid >> 4, c8 = tid & 15;
            const size_t r0 = (size_t)(rbase + (d ? 63 - j : j)), r1 = (size_t)(rbase + (d ? 31 - j : 32 + j));
            pc0[d] = *(const uint4*)(XBC + r0 * P2LD + 3072 + 128 * g + 8 * c8); pb0[d] = *(const uint4*)(XBC + r0 * P2LD + 2048 + 128 * g + 8 * c8);
            pc1[d] = *(const uint4*)(XBC + r1 * P2LD + 3072 + 128 * g + 8 * c8); pb1[d] = *(const uint4*)(XBC + r1 * P2LD + 2048 + 128 * g + 8 * c8);
            const int jx = NP == 1 ? (tid & 255) >> 2 : tid >> 3, cx = NP == 1 ? (tid & 3) : (tid & 7);
            px[d] = *(const uint4*)(XBC + (size_t)(rbase + (d ? 63 - jx : jx)) * P2LD + 64 * h + p0 + 8 * cx);
        }
#pragma unroll
        for (int d = 0; d < 2; ++d) {
            unsigned char* base = lds_ + d * SET;
            lbf16* Cm = (lbf16*)(base + SS_CM); lbf16* Bm = (lbf16*)(base + SS_BM); lbf16* Xa = (lbf16*)(base + OXA); lbf16* Xb = (lbf16*)(base + OXB); lbf16* Sbf = (lbf16*)(base + OSBF);
            const lf32* cumL = cumT + d * CS + 64 * step;
#pragma unroll
            for (int tp = 0; tp < 2 * NP; ++tp) st4_bf16(Sbf + (16 * tp + l15) * 136 + 16 * wave + q4, S[d][tp]);
            const float cend = cumL[63];
            {
                const int j = tid >> 4, c8 = tid & 15;
                st16_lds(Cm + j * 136 + 8 * c8, pc0[d]); st16_lds(Bm + j * 136 + 8 * c8, pb0[d]);
                st16_lds(Cm + (32 + j) * 136 + 8 * c8, pc1[d]); st16_lds(Bm + (32 + j) * 136 + 8 * c8, pb1[d]);
            }
            if (NP == 2 || (tid >> 8) == d) {
                const int j = NP == 1 ? (tid & 255) >> 2 : tid >> 3, c8 = NP == 1 ? (tid & 3) : (tid & 7);
                float xf[8], xg[8]; unpack8(px[d], xf);
                const float cj = cumL[j], cp = j ? cumL[j - 1] : 0.f;
                const float dtv = (cj - cp) * inv_a[d], dtd = dtv * __expf(cend - cj);
#pragma unroll
                for (int e = 0; e < 8; ++e) { xg[e] = xf[e] * dtd; xf[e] *= dtv; }
                st16_lds(Xa + j * XS + 8 * c8, pack8(xf));
                st16_lds(Xb + j * XS + 8 * c8, pack8(xg));
            }
        }
        asm volatile("s_waitcnt vmcnt(0)" ::: "memory");
        __syncthreads();
        uint2 yrd[2][NP], xrd[NP];
        bf16_t* ypd[2][NP];
#pragma unroll
        for (int d = 0; d < 2; ++d) {
            const int rbase = row0 + 64 * (d ? nc - 1 - step : step);
            const size_t row = (size_t)(rbase + (d ? 63 - o_t : o_t));
#pragma unroll
            for (int i = 0; i < NP; ++i) {
                const int o_tp = NP * (wave & 1) + i, phi = NP == 1 ? ph : (o_tp >> 1);
                ypd[d][i] = YS + ((size_t)(phi * 32 + h) * M_ROWS + row) * 32 + 16 * (o_tp & 1) + q4;
                const bf16_t* xsrc = XBC + row * P2LD + 64 * h + p0 + 16 * o_tp + q4;
                yrd[d][i] = *(const uint2*)(first ? xsrc : (const bf16_t*)ypd[d][i]);
                if (d == 0) xrd[i] = *(const uint2*)xsrc;
            }
        }
#pragma unroll
        for (int d = 0; d < 2; ++d) {
            unsigned char* base = lds_ + d * SET;
            lbf16* Cm = (lbf16*)(base + SS_CM); lbf16* Bm = (lbf16*)(base + SS_BM); lbf16* Wm = (lbf16*)(base + OW);
            const lf32* cumL = cumT + d * CS + 64 * step;
            {
                const int tt = wave >> 1, ts0 = 2 * (wave & 1);
                f32x4_t accs[2]; accs[0] = (f32x4_t){0.f, 0.f, 0.f, 0.f}; accs[1] = accs[0];
                if (ts0 <= tt) mma16_2A<128>(accs[0], accs[1], Bm + ts0 * 16 * 136, Bm + (ts0 + 1) * 16 * 136, 136, Cm + tt * 16 * 136, 136, lane);
                const int t = 16 * tt + l15;
                const float ct = cumL[t];
#pragma unroll
                for (int i = 0; i < 2; ++i) {
                    const int sb = 16 * (ts0 + i) + q4;
                    const f32x4_t cs = *(const __attribute__((address_space(3))) f32x4_t*)(cumL + sb);
                    f32x4_t acc = accs[i];
#pragma unroll
                    for (int r = 0; r < 4; ++r) { const float e = __expf(fminf(ct - cs[r], 0.f)); acc[r] = (sb + r <= t) ? acc[r] * e : 0.f; }
                    st4_bf16(Wm + t * 72 + sb, acc);
                }
            }
        }
        __syncthreads();
#pragma unroll
        for (int d = 0; d < 2; ++d) {
            unsigned char* base = lds_ + d * SET;
            lbf16* Cm = (lbf16*)(base + SS_CM); lbf16* Bm = (lbf16*)(base + SS_BM); lbf16* Xa = (lbf16*)(base + OXA); lbf16* Xb = (lbf16*)(base + OXB);
            lbf16* Wm = (lbf16*)(base + OW); lbf16* Sbf = (lbf16*)(base + OSBF);
            const lf32* cumL = cumT + d * CS + 64 * step;
            const int rbase = row0 + 64 * (d ? nc - 1 - step : step);
#pragma unroll
            for (int i = 0; i < NP; ++i) {
                const int o_tp = NP * (wave & 1) + i;
                f32x4_t acc = (f32x4_t){0.f, 0.f, 0.f, 0.f};
                acc = mma16<128>(acc, Sbf + o_tp * 16 * 136, 136, Cm + o_tt * 16 * 136, 136, lane);
                acc *= __expf(cumL[o_t]);
                acc = mma16_tA<64>(acc, Xa, XS, 16 * o_tp, Wm + o_tt * 16 * 72, 72, lane);
                if (d == 0) {
                    acc[0] += dsk * __uint_as_float(xrd[i].x << 16); acc[1] += dsk * __uint_as_float(xrd[i].x & 0xffff0000u);
                    acc[2] += dsk * __uint_as_float(xrd[i].y << 16); acc[3] += dsk * __uint_as_float(xrd[i].y & 0xffff0000u);
                }
                {
                    uint2 yr = yrd[d][i];
                    if (first) yr = make_uint2(0u, 0u);
                    acc[0] += __uint_as_float(yr.x << 16); acc[1] += __uint_as_float(yr.x & 0xffff0000u);
                    acc[2] += __uint_as_float(yr.y << 16); acc[3] += __uint_as_float(yr.y & 0xffff0000u);
                }
                bf16_t* yp = ypd[d][i];
                uint2 w; w.x = pg8::cvt_pk_bf16(acc[0], acc[1]); w.y = pg8::cvt_pk_bf16(acc[2], acc[3]);
                *(uint2*)yp = w;
            }
            {
                const float ee = __expf(cumL[63]);
#pragma unroll
                for (int tp = 0; tp < 2 * NP; ++tp) S[d][tp] *= ee;
#pragma unroll
                for (int gp = 0; gp < NP; ++gp) mma16_tAB_2B<64>(S[d][2 * gp], S[d][2 * gp + 1], Bm, 136, 16 * wave, Xb, XS, 32 * gp, 32 * gp + 16, lane);
            }
        }
        __syncthreads();
    }
    if (sid < 32) {
#pragma unroll
        for (int d = 0; d < 2; ++d)
#pragma unroll
            for (int tp = 0; tp < 2 * NP; ++tp)
                *(f32x4_t*)(out_s + ((size_t)(sid * 2 + d) * 32 + h) * 8192 + (size_t)(p0 + 16 * tp + l15) * 128 + 16 * wave + q4) = S[d][tp];
    }
}

constexpr int S1_CM = 0, S1_BM = 17408, S1_XA = 34816, S1_XB = 44032, S1_W = 53248, S1_SBF = 62464, S1_CUM = 79872;
DEV void job_ssd_1dir(const int sid, const int h, const int d, unsigned char* lds_, int tid, const bf16_t* XBC, const float* DT, const float* dt_bias, const float* a_log,
                      const float* dskip, const float* s0, bf16_t* Yout, const int yrows, const int yrow0) {
    lbf16* Cm = (lbf16*)(lds_ + S1_CM); lbf16* Bm = (lbf16*)(lds_ + S1_BM); lbf16* Xa = (lbf16*)(lds_ + S1_XA); lbf16* Xb = (lbf16*)(lds_ + S1_XB);
    lbf16* Wm = (lbf16*)(lds_ + S1_W); lbf16* Sbf = (lbf16*)(lds_ + S1_SBF); lf32* cumT = (lf32*)(lds_ + S1_CUM);
    int row0, T; seq_info(sid, row0, T);
    const int nc = T >> 6, g = h >> 2, lane = tid & 63, wave = tid >> 6, q4 = (lane >> 4) * 4, l15 = lane & 15;
    f32x4_t S[4];
    const float inv_a = -__expf(-a_log[d * 32 + h]);
#pragma unroll
    for (int tp = 0; tp < 4; ++tp) S[tp] = *(const f32x4_t*)(s0 + ((size_t)((sid - 32) * 2 + d) * 32 + h) * 8192 + (size_t)(16 * tp + l15) * 128 + 16 * wave + q4);
    const float dsk = d == 0 ? dskip[h] : 0.f * dskip[h];
    {
        const float bias = dt_bias[d * 32 + h], a_d = -__expf(a_log[d * 32 + h]);
        float dv[8];
#pragma unroll
        for (int k = 0; k < 8; ++k) { const int step = wave + 8 * k, cidx = d ? nc - 1 - step : step; dv[k] = DT[(size_t)(row0 + 64 * cidx + (d ? 63 - lane : lane)) * 64 + d * 32 + h]; }
#pragma unroll
        for (int k = 0; k < 8; ++k) cumT[64 * (wave + 8 * k) + lane] = wave_incl_scan_add(softplusf_(dv[k] + bias) * a_d, lane);
    }
    __syncthreads();
    const int o_tt = wave >> 1, o_t = 16 * o_tt + l15;
    for (int step = 0; step < nc; ++step) {
        const int rbase = row0 + 64 * (d ? nc - 1 - step : step);
        const lf32* cumL = cumT + 64 * step;
        uint4 pc0, pb0, pc1, pb1, px;
        {
            const int j = tid >> 4, c8 = tid & 15;
            const size_t r0 = (size_t)(rbase + (d ? 63 - j : j)), r1 = (size_t)(rbase + (d ? 31 - j : 32 + j));
            pc0 = *(const uint4*)(XBC + r0 * P2LD + 3072 + 128 * g + 8 * c8); pb0 = *(const uint4*)(XBC + r0 * P2LD + 2048 + 128 * g + 8 * c8);
            pc1 = *(const uint4*)(XBC + r1 * P2LD + 3072 + 128 * g + 8 * c8); pb1 = *(const uint4*)(XBC + r1 * P2LD + 2048 + 128 * g + 8 * c8);
            const int jx = tid >> 3, cx = tid & 7;
            px = *(const uint4*)(XBC + (size_t)(rbase + (d ? 63 - jx : jx)) * P2LD + 64 * h + 8 * cx);
        }
#pragma unroll
        for (int tp = 0; tp < 4; ++tp) st4_bf16(Sbf + (16 * tp + l15) * 136 + 16 * wave + q4, S[tp]);
        const float cend = cumL[63];
        {
            const int j = tid >> 4, c8 = tid & 15;
            st16_lds(Cm + j * 136 + 8 * c8, pc0); st16_lds(Bm + j * 136 + 8 * c8, pb0);
            st16_lds(Cm + (32 + j) * 136 + 8 * c8, pc1); st16_lds(Bm + (32 + j) * 136 + 8 * c8, pb1);
        }
        {
            const int j = tid >> 3, c8 = tid & 7;
            float xf[8], xg[8]; unpack8(px, xf);
            const float cj = cumL[j], cp = j ? cumL[j - 1] : 0.f;
            const float dtv = (cj - cp) * inv_a, dtd = dtv * __expf(cend - cj);
#pragma unroll
            for (int e = 0; e < 8; ++e) { xg[e] = xf[e] * dtd; xf[e] *= dtv; }
            st16_lds(Xa + j * 72 + 8 * c8, pack8(xf));
            st16_lds(Xb + j * 72 + 8 * c8, pack8(xg));
        }
        __syncthreads();
        uint2 xrd[2];
        const size_t orow = (size_t)(rbase + (d ? 63 - o_t : o_t));
#pragma unroll
        for (int i = 0; i < 2; ++i) xrd[i] = *(const uint2*)(XBC + orow * P2LD + 64 * h + 16 * (2 * (wave & 1) + i) + q4);
        {
            const int tt = wave >> 1, ts0 = 2 * (wave & 1);
            f32x4_t accs[2]; accs[0] = (f32x4_t){0.f, 0.f, 0.f, 0.f}; accs[1] = accs[0];
            if (ts0 <= tt) mma16_2A<128>(accs[0], accs[1], Bm + ts0 * 16 * 136, Bm + (ts0 + 1) * 16 * 136, 136, Cm + tt * 16 * 136, 136, lane);
            const int t = 16 * tt + l15;
            const float ct = cumL[t];
#pragma unroll
            for (int i = 0; i < 2; ++i) {
                const int sb = 16 * (ts0 + i) + q4;
                const f32x4_t cs = *(const __attribute__((address_space(3))) f32x4_t*)(cumL + sb);
                f32x4_t acc = accs[i];
#pragma unroll
                for (int r = 0; r < 4; ++r) { const float e = __expf(fminf(ct - cs[r], 0.f)); acc[r] = (sb + r <= t) ? acc[r] * e : 0.f; }
                st4_bf16(Wm + t * 72 + sb, acc);
            }
        }
        __syncthreads();
#pragma unroll
        for (int i = 0; i < 2; ++i) {
            const int o_tp = 2 * (wave & 1) + i;
            f32x4_t acc = (f32x4_t){0.f, 0.f, 0.f, 0.f};
            acc = mma16<128>(acc, Sbf + o_tp * 16 * 136, 136, Cm + o_tt * 16 * 136, 136, lane);
            acc *= __expf(cumL[o_t]);
            acc = mma16_tA<64>(acc, Xa, 72, 16 * o_tp, Wm + o_tt * 16 * 72, 72, lane);
            acc[0] += dsk * __uint_as_float(xrd[i].x << 16); acc[1] += dsk * __uint_as_float(xrd[i].x & 0xffff0000u);
            acc[2] += dsk * __uint_as_float(xrd[i].y << 16); acc[3] += dsk * __uint_as_float(xrd[i].y & 0xffff0000u);
            uint2 w; w.x = pg8::cvt_pk_bf16(acc[0], acc[1]); w.y = pg8::cvt_pk_bf16(acc[2], acc[3]);
            *(uint2*)(Yout + ((size_t)((o_tp >> 1) * 32 + h) * yrows + (orow - yrow0)) * 32 + 16 * (o_tp & 1) + q4) = w;
        }
        {
            const float ee = __expf(cumL[63]);
#pragma unroll
            for (int tp = 0; tp < 4; ++tp) S[tp] *= ee;
#pragma unroll
            for (int gp = 0; gp < 2; ++gp) mma16_tAB_2B<64>(S[2 * gp], S[2 * gp + 1], Bm, 136, 16 * wave, Xb, 72, 32 * gp, 32 * gp + 16, lane);
        }
        __syncthreads();
    }
}

constexpr int ML_QM = 0, ML_KM = 17408, ML_KDT = 34816  , ML_VT = 52224  , ML_SM = 57856, ML_CT = 67072, ML_F32 = 75776, ML_TAB = 77312, ML_VT2 = 131072  , ML_CT2 = 140288  ;
template <int NT>
DEV void job_mlstm_chunked(const int sid, const int h, const int vq, const int d, unsigned char* lds_, int tid, const bf16_t* P, const float* GATES, const float* gate_b,
                           const float* c0, const float* n0, const float* m0, bf16_t* HAD, bf16_t* HAD2, float* out_c, float* out_n, float* out_m) {
    lbf16* Qm = (lbf16*)(lds_ + ML_QM); lbf16* Km = (lbf16*)(lds_ + ML_KM); lbf16* KdT = (lbf16*)(lds_ + ML_KDT); lbf16* VT = (lbf16*)(lds_ + (NT == 1 ? ML_VT : ML_VT2)); constexpr int VS = NT == 1 ? 40 : 72;
    lbf16* Sm = (lbf16*)(lds_ + ML_SM); lbf16* CT = (lbf16*)(lds_ + (NT == 1 ? ML_CT : ML_CT2));
    lf32* denL = (lf32*)(lds_ + ML_F32) + 192; lf32* nL = (lf32*)(lds_ + ML_F32) + 256;
    lf32* uT = (lf32*)(lds_ + ML_TAB); lf32* pmT = uT + 4096; lf32* bT = uT + 8192;
    int row0, T; seq_info(sid, row0, T);
    const int nc = T >> 6, lane = tid & 63, wave = tid >> 6, q4 = (lane >> 4) * 4, l15 = lane & 15;
    const int v0 = 32 * NT * vq;
    f32x4_t C[2 * NT];
    float m_prev = 0.f;
    if (sid >= 32) {
        const size_t base = (size_t)((sid - 32) * 2 + d) * 4 + h;
#pragma unroll
        for (int tv = 0; tv < 2 * NT; ++tv)
#pragma unroll
            for (int r = 0; r < 4; ++r) C[tv][r] = c0[base * 16384 + (size_t)(16 * wave + q4 + r) * 128 + v0 + 16 * tv + l15];
        if (tid < 128) nL[tid] = n0[base * 128 + tid];
        m_prev = m0[base];
    } else {
#pragma unroll
        for (int tv = 0; tv < 2 * NT; ++tv) C[tv] = (f32x4_t){0.f, 0.f, 0.f, 0.f};
        if (tid < 128) nL[tid] = 0.f;
    }
    bf16_t* HADg[NT];
#pragma unroll
    for (int g = 0; g < NT; ++g) HADg[g] = had_slab(HAD, HAD2, (d * 4 + NT * vq + g) * 4 + h);
    {
        const float gbi = gate_b[(0 * 2 + d) * 4 + h], gbf = gate_b[(1 * 2 + d) * 4 + h];
        if (nc == 64) {
            float gi[8], gf[8];
#pragma unroll
            for (int k = 0; k < 8; ++k) { const int step = wave + 8 * k; const size_t row = (size_t)(row0 + 64 * (d ? nc - 1 - step : step) + (d ? 63 - lane : lane));
                gi[k] = GATES[row * 16 + (0 * 2 + d) * 4 + h]; gf[k] = GATES[row * 16 + (1 * 2 + d) * 4 + h]; }
#pragma unroll
            for (int k = 0; k < 8; ++k) { const int step = wave + 8 * k;
                const float b = wave_incl_scan_add(logsigmoidf_(gf[k] + gbf), lane), u = gi[k] + gbi - b;
                uT[64 * step + lane] = u; pmT[64 * step + lane] = wave_incl_scan_max(u, lane); bT[64 * step + lane] = b; }
        } else {
            for (int step = wave; step < nc; step += 8) {
                const size_t row = (size_t)(row0 + 64 * (d ? nc - 1 - step : step) + (d ? 63 - lane : lane));
                const float li = GATES[row * 16 + (0 * 2 + d) * 4 + h] + gbi;
                const float lf = logsigmoidf_(GATES[row * 16 + (1 * 2 + d) * 4 + h] + gbf);
                const float b = wave_incl_scan_add(lf, lane);
                const float u = li - b;
                uT[64 * step + lane] = u; pmT[64 * step + lane] = wave_incl_scan_max(u, lane); bT[64 * step + lane] = b;
            }
        }
    }
    __syncthreads();
    uint4 nq[2], nk[2], nvr;
#define ML_LOADP(stp) do { const int rb_ = row0 + 64 * (d ? nc - 1 - (stp) : (stp)); \
        _Pragma("unroll") for (int i_ = 0; i_ < 2; ++i_) { const int idx_ = tid + 512 * i_, j_ = idx_ >> 4, c8_ = idx_ & 15; const size_t row_ = (size_t)(rb_ + (d ? 63 - j_ : j_)); \
            nq[i_] = *(const uint4*)(P + row_ * PLD + 128 * h + 8 * c8_); nk[i_] = *(const uint4*)(P + row_ * PLD + 512 + 128 * h + 8 * c8_); } \
        { const int j_ = NT == 1 ? (tid & 255) >> 2 : tid >> 3, c8_ = NT == 1 ? (tid & 3) : (tid & 7); nvr = *(const uint4*)(P + (size_t)(rb_ + (d ? 63 - j_ : j_)) * PLD + 1024 + 128 * h + v0 + 8 * c8_); } } while (0)
    ML_LOADP(0);
    for (int step = 0; step < nc; ++step) {
        const int cidx = d ? nc - 1 - step : step;
        const int rbase = row0 + 64 * cidx;
        const lf32* uL = uT + 64 * step; const lf32* pmL = pmT + 64 * step; const lf32* bL = bT + 64 * step;
#pragma unroll
        for (int tv = 0; tv < 2 * NT; ++tv) st4_bf16(CT + (16 * tv + l15) * 136 + 16 * wave + q4, C[tv]);
        const float Mend = fmaxf(m_prev, pmL[63]);
#pragma unroll
        for (int i = 0; i < 2; ++i) {
            const int idx = tid + 512 * i, j = idx >> 4, c8 = idx & 15;
            const uint4 qr = nq[i];
            const uint4 kr = nk[i];
            st16_lds(Qm + j * 136 + 8 * c8, qr);
            float kf[8]; unpack8(kr, kf);
#pragma unroll
            for (int e = 0; e < 8; ++e) kf[e] *= 0.08838834764831845f;
            st16_lds(Km + j * 136 + 8 * c8, pack8(kf));
            const float sc = __expf(uL[j] - Mend);
#pragma unroll
            for (int e = 0; e < 8; ++e) kf[e] *= sc;
            st16_lds(KdT + j * 136 + 8 * c8, pack8(kf));
        }
        {
            const int j = NT == 1 ? (tid & 255) >> 2 : tid >> 3, c8 = NT == 1 ? (tid & 3) : (tid & 7);
            st16_lds(VT + j * VS + 8 * c8, nvr);
        }
        __syncthreads();
        { const int nstep = step + 1 < nc ? step + 1 : step; ML_LOADP(nstep); }
        {
            const int tt = wave >> 1, ts0 = 2 * (wave & 1);
            f32x4_t accs[2]; accs[0] = (f32x4_t){0.f, 0.f, 0.f, 0.f}; accs[1] = accs[0];
            if (ts0 <= tt) mma16_2A<128>(accs[0], accs[1], Km + ts0 * 16 * 136, Km + (ts0 + 1) * 16 * 136, 136, Qm + tt * 16 * 136, 136, lane);
            const int t = 16 * tt + l15;
            const float Mt = fmaxf(m_prev, pmL[t]);
#pragma unroll
            for (int i = 0; i < 2; ++i) {
                const int sb = 16 * (ts0 + i) + q4;
                const f32x4_t us = *(const __attribute__((address_space(3))) f32x4_t*)(uL + sb);
                f32x4_t acc = accs[i];
#pragma unroll
                for (int r = 0; r < 4; ++r) { const float e = __expf(fminf(us[r] - Mt, 0.f)); acc[r] = (sb + r <= t) ? acc[r] * e : 0.f; }
                st4_bf16(Sm + t * 72 + sb, acc);
            }
        }
        __syncthreads();
        {
            const int t = tid >> 3, part = tid & 7;
            float ssum = 0.f, qn = 0.f;
            {
                float sf[8]; const u32x4_t sr = *(const __attribute__((address_space(3))) u32x4_t*)(Sm + t * 72 + part * 8);
                uint4 s4; s4.x = sr.x; s4.y = sr.y; s4.z = sr.z; s4.w = sr.w; unpack8(s4, sf);
#pragma unroll
                for (int e = 0; e < 8; ++e) ssum += sf[e];
#pragma unroll
                for (int hh = 0; hh < 2; ++hh) {
                    float qf[8]; const u32x4_t qr = *(const __attribute__((address_space(3))) u32x4_t*)(Qm + t * 136 + part * 16 + 8 * hh);
                    uint4 q4v; q4v.x = qr.x; q4v.y = qr.y; q4v.z = qr.z; q4v.w = qr.w; unpack8(q4v, qf);
                    const f32x4_t n0 = *(const __attribute__((address_space(3))) f32x4_t*)(nL + part * 16 + 8 * hh), n1 = *(const __attribute__((address_space(3))) f32x4_t*)(nL + part * 16 + 8 * hh + 4);
                    qn += qf[0] * n0[0] + qf[1] * n0[1] + qf[2] * n0[2] + qf[3] * n0[3] + qf[4] * n1[0] + qf[5] * n1[1] + qf[6] * n1[2] + qf[7] * n1[3];
                }
            }
            float tot = ssum + __expf(m_prev - fmaxf(m_prev, pmL[t])) * qn;
            tot += __shfl_xor(tot, 1); tot += __shfl_xor(tot, 2); tot += __shfl_xor(tot, 4);
            if (part == 0) denL[t] = tot;
        }
        __syncthreads();
#pragma unroll
        for (int i = 0; i < NT; ++i) {
            const int tt = wave >> 1, tv = NT * (wave & 1) + i;
            f32x4_t acc = (f32x4_t){0.f, 0.f, 0.f, 0.f};
            acc = mma16<128>(acc, CT + tv * 16 * 136, 136, Qm + tt * 16 * 136, 136, lane);
            const int t = 16 * tt + l15;
            const float Mt = fmaxf(m_prev, pmL[t]);
            acc *= __expf(m_prev - Mt);
            acc = mma16_tA<64>(acc, VT, VS, 16 * tv, Sm + tt * 16 * 72, 72, lane);
            const float dn = fmaxf(fabsf(denL[t]), __expf(-(bL[t] + Mt)));
            const float inv = __builtin_amdgcn_rcpf(dn);
            acc *= inv;
            const size_t row = (size_t)(rbase + (d ? 63 - t : t));
            uint2 w; w.x = pg8::cvt_pk_bf16(acc[0], acc[1]); w.y = pg8::cvt_pk_bf16(acc[2], acc[3]);
            *(uint2*)(HADg[tv >> 1] + row * 32 + 16 * (tv & 1) + q4) = w;
        }
        {
            const float fC = __expf(m_prev - Mend);
#pragma unroll
            for (int tv = 0; tv < 2 * NT; ++tv) C[tv] *= fC;
#pragma unroll
            for (int g = 0; g < NT; ++g) mma16_tAB_2B<64>(C[2 * g], C[2 * g + 1], KdT, 136, 16 * wave, VT, VS, 32 * g, 32 * g + 16, lane);
            const int k = tid >> 2, part = tid & 3;
            float ks = 0.f;
#pragma unroll
            for (int e = 0; e < 16; ++e) ks += bf2f(KdT[(part * 16 + e) * 136 + k]);
            ks += __shfl_xor(ks, 1); ks += __shfl_xor(ks, 2);
            if (part == 0) nL[k] = fC * nL[k] + ks;
        }
        m_prev = bL[63] + Mend;
        __syncthreads();
    }
    if (sid < 32) {
        const size_t base = (size_t)(sid * 2 + d) * 4 + h;
#pragma unroll
        for (int tv = 0; tv < 2 * NT; ++tv)
#pragma unroll
            for (int r = 0; r < 4; ++r) out_c[base * 16384 + (size_t)(16 * wave + q4 + r) * 128 + v0 + 16 * tv + l15] = C[tv][r];
        if (vq == 0) {
            if (tid < 128) out_n[base * 128 + tid] = nL[tid];
            if (tid == 0) out_m[base] = m_prev;
        }
    }
}

DEV int zrow_of(int sid, int d, int row) { const int t = (row - 8192) & 4095; return (sid - 32) * 2048 + (d ? t : t - 2048); }
DEV void job_rwkv_fixup(const int sid, const int hd, const int d, const int cg, unsigned char* lds_, int tid, const float* SMID, const bf16_t* ZB, const bf16_t* YBD, bf16_t* YBD2) {
    lbf16* Sb = (lbf16*)(lds_); lbf16* Zt = (lbf16*)(lds_ + 9216);
    const int lane = tid & 63, wave = tid >> 6, q4 = (lane >> 4) * 4, l15 = lane & 15;
    int row0, T; seq_info(sid, row0, T);
    const int nc = T >> 6;
    {
        const int v = tid >> 3, k8 = (tid & 7) * 8;
        const float* sp = SMID + ((size_t)((sid - 32) * 2 + d) * 8 + hd) * 4096 + v * 64 + k8;
        float f[8];
#pragma unroll
        for (int e = 0; e < 8; ++e) f[e] = sp[e];
        st16_lds(Sb + v * 72 + k8, pack8(f));
    }
    YBD += ((size_t)(d * 8 + hd) * M_ROWS) * 64; YBD2 += ((size_t)(d * 8 + hd) * M_ROWS) * 64;
    const int st0 = (nc >> 1) + 4 * cg, tt = wave >> 1;
    uint4 zq[4]; uint2 yq[4][2];
#pragma unroll
    for (int k = 0; k < 4; ++k) {
        const int cidx = d ? nc - 1 - (st0 + k) : st0 + k, rbase = row0 + 64 * cidx;
        { const int j = tid >> 3, c8 = (tid & 7) * 8; zq[k] = *(const uint4*)(ZB + ((size_t)(d * 8 + hd) * 4096 + zrow_of(sid, d, rbase + (d ? 63 - j : j))) * 64 + c8); }
#pragma unroll
        for (int i = 0; i < 2; ++i) { const int t = 16 * tt + l15; yq[k][i] = *(const uint2*)(YBD + (size_t)(rbase + (d ? 63 - t : t)) * 64 + 16 * (2 * (wave & 1) + i) + q4); }
    }
#pragma unroll
    for (int k = 0; k < 4; ++k) {
        const int cidx = d ? nc - 1 - (st0 + k) : st0 + k, rbase = row0 + 64 * cidx;
        lbf16* Zc = Zt + ((k & 1) ? 64 * 72 : 0);
        { const int j = tid >> 3, c8 = (tid & 7) * 8; st16_lds(Zc + j * 72 + c8, zq[k]); }
        __syncthreads();
#pragma unroll
        for (int i = 0; i < 2; ++i) {
            const int tv = 2 * (wave & 1) + i;
            f32x4_t acc = (f32x4_t){0.f, 0.f, 0.f, 0.f};
            acc = mma16<64>(acc, Sb + tv * 16 * 72, 72, Zc + tt * 16 * 72, 72, lane);
            const int t = 16 * tt + l15;
            const size_t yo = (size_t)(rbase + (d ? 63 - t : t)) * 64 + 16 * tv + q4;
            const uint2 yr = yq[k][i];
            acc[0] += __uint_as_float(yr.x << 16); acc[1] += __uint_as_float(yr.x & 0xffff0000u);
            acc[2] += __uint_as_float(yr.y << 16); acc[3] += __uint_as_float(yr.y & 0xffff0000u);
            uint2 w; w.x = pg8::cvt_pk_bf16(acc[0], acc[1]); w.y = pg8::cvt_pk_bf16(acc[2], acc[3]);
            *(uint2*)(YBD2 + yo) = w;
        }
    }
    __syncthreads();
}
constexpr int RW_VT = 0, RW_KQ = 9216, RW_RT = 20480, RW_KHT = 29696, RW_AHT = 38912, RW_SA = 48128, RW_SB = 59392, RW_RR = 68608, RW_KR = 77824,
              RW_F0 = 87040, RW_F1 = 100352, RW_SBF = 117760, RW_PAR = 126976, RW_AUPT = 129024, RW_WUPT = 138240, RW_TBT = 147456, RW_END = 153600;
DEV void job_rwkv_chunked(const int sid, const int hd, const int d, const int seg, unsigned char* lds_, int tid, const bf16_t* P, const float* w0, const bf16_t* UPT, const float* a0,
                          const float* k_k, const float* k_a, const float* u, const float* s0, bf16_t* YBD, float* RK, float* out_s, float* SMID, bf16_t* ZB) {
    lbf16* AUPT = (lbf16*)(lds_ + RW_AUPT); lbf16* WUPT = (lbf16*)(lds_ + RW_WUPT); lbf16* VT = (lbf16*)(lds_ + RW_VT);
    lbf16* KQ = (lbf16*)(lds_ + RW_KQ); lbf16* UT = KQ;
    lbf16* RT = (lbf16*)(lds_ + RW_RT); lbf16* KHT = (lbf16*)(lds_ + RW_KHT); lbf16* AHT = (lbf16*)(lds_ + RW_AHT);
    lbf16* SA = (lbf16*)(lds_ + RW_SA);
    lbf16* SB = (lbf16*)(lds_ + RW_SB);
    lbf16* RR = (lbf16*)(lds_ + RW_RR); lbf16* KR = (lbf16*)(lds_ + RW_KR);
    lbf16* aL = (lbf16*)(lds_ + RW_F0); lf32* cumL = (lf32*)(lds_ + RW_F1);
    lbf16* BRA = (lbf16*)(lds_ + RW_F0); lf32* NdL = (lf32*)(lds_ + RW_F0 + 9216);
    lbf16* BRK = (lbf16*)(lds_ + RW_F1);
    lbf16* TBT = (lbf16*)(lds_ + RW_TBT);
    lbf16* SBF = (lbf16*)(lds_ + RW_SBF);
    lf32* par = (lf32*)(lds_ + RW_PAR); lf32* pa0 = par; lf32* pw0 = par + 64; lf32* pkk = par + 128; lf32* pka = par + 192; lf32* pus = par + 256; lf32* invn = par + 320; lf32* lamL = par + 448;
    int row0, T; seq_info(sid, row0, T);
    const int nc = T >> 6, lane = tid & 63, wave = tid >> 6, q4 = (lane >> 4) * 4, l15 = lane & 15;
    const int gc0 = 64 * hd;
    {
        if (tid < 64) { pa0[tid] = a0[gc0 + tid]; pw0[tid] = w0[d * 512 + gc0 + tid]; pkk[tid] = k_k[gc0 + tid]; pka[tid] = k_a[gc0 + tid]; pus[tid] = u[gc0 + tid] + u[512 + gc0 + tid]; }
        for (int i = tid; i < 64 * 88; i += 512) { UT[i] = 0; SA[i] = 0; }
        for (int i = tid; i < 4 * 32 * 24; i += 512) TBT[i] = 0;
        const int j = tid >> 3, c8 = (tid & 7) * 8;
        st16_lds(AUPT + j * 72 + c8, *(const uint4*)(UPT + (size_t)hd * 4096 + j * 64 + c8));
        st16_lds(WUPT + j * 72 + c8, *(const uint4*)(UPT + (size_t)(8 + d * 8 + hd) * 4096 + j * 64 + c8));
    }
    __syncthreads();
    f32x4_t S[2];
    const int s_tv = wave >> 1;
#pragma unroll
    for (int i = 0; i < 2; ++i) {
        const int tk = 2 * (wave & 1) + i;
        if (seg == 3) { for (int r = 0; r < 4; ++r) S[i][r] = (16 * tk + q4 + r == 16 * s_tv + l15) ? 1.f : 0.f; }
        else if (sid >= 32 && seg < 2) S[i] = *(const f32x4_t*)(s0 + ((size_t)((sid - 32) * 2 + d) * 8 + hd) * 4096 + (size_t)(16 * s_tv + l15) * 64 + 16 * tk + q4);
        else S[i] = (f32x4_t){0.f, 0.f, 0.f, 0.f};
    }
    YBD += ((size_t)(d * 8 + hd) * M_ROWS) * 64;
    const int st_lo = seg >= 2 ? (nc >> 1) : 0, st_hi = seg == 1 ? (nc >> 1) : nc;
    uint4 nr, nk, na, nw, nv;
#define RW_LOADP(stp) do { const int j_ = tid >> 3, c8_ = (tid & 7) * 8; const int cidx_ = d ? nc - 1 - (stp) : (stp); \
        const bf16_t* pr_ = P + (size_t)(row0 + 64 * cidx_ + (d ? 63 - j_ : j_)) * PLD + 2064; \
        nr = *(const uint4*)(pr_ + gc0 + c8_); nk = *(const uint4*)(pr_ + 512 + gc0 + c8_); na = *(const uint4*)(pr_ + 1664 + c8_); \
        nw = *(const uint4*)(pr_ + 1536 + 64 * d + c8_); nv = *(const uint4*)(pr_ + 1024 + gc0 + c8_); } while (0)
    RW_LOADP(st_lo);
    for (int step = st_lo; step < st_hi; ++step) {
        const int cidx = d ? nc - 1 - step : step;
        const int rbase = row0 + 64 * cidx;
        {
            const int j = tid >> 3, c8 = (tid & 7) * 8;
            st16_lds(RR + j * 72 + c8, nr);
            st16_lds(KR + j * 72 + c8, nk);
            st16_lds(SB + j * 72 + c8, na);
            float wf[8]; unpack8(nw, wf);
#pragma unroll
            for (int e = 0; e < 8; ++e) { const float x2 = fminf(fmaxf(wf[e], -15.f), 15.f); const float ex = __expf(2.f * x2); wf[e] = (ex - 1.f) * __builtin_amdgcn_rcpf(ex + 1.f); }
            st16_lds(SA + j * 88 + c8, pack8(wf));
            { uint4 vv = nv; if (seg == 3) vv = make_uint4(0u, 0u, 0u, 0u); st16_lds(VT + j * 72 + c8, vv); }
#pragma unroll
            for (int i = 0; i < 2; ++i) st4_bf16(SBF + (16 * s_tv + l15) * 72 + 16 * (2 * (wave & 1) + i) + q4, S[i]);
        }
        __syncthreads();
        {
            const int tt = wave >> 1;
#pragma unroll
            for (int i = 0; i < 2; ++i) {
                const int tc = 2 * (wave & 1) + i;
                f32x4_t za = (f32x4_t){0.f, 0.f, 0.f, 0.f}, zw = za;
                za = mma16<64>(za, AUPT + tc * 16 * 72, 72, SB + tt * 16 * 72, 72, lane);
                zw = mma16<64>(zw, WUPT + tc * 16 * 72, 72, SA + tt * 16 * 88, 88, lane);
                const int t = 16 * tt + l15, c = 16 * tc + q4;
                f32x4_t av, wv;
#pragma unroll
                for (int r = 0; r < 4; ++r) { av[r] = sigmoidf_(pa0[c + r] + za[r]); wv[r] = -0.606531f * sigmoidf_(pw0[c + r] + zw[r]); }
                st4_bf16(aL + t * 72 + c, av);
                *(__attribute__((address_space(3))) f32x4_t*)(cumL + t * 68 + c) = wv;
            }
        }
        __syncthreads();
        if (tid < 256) {
            const int k = tid >> 2, part = tid & 3;
            float v[16]; float run = 0.f;
#pragma unroll
            for (int e = 0; e < 16; ++e) { run += cumL[(part * 16 + e) * 68 + k]; v[e] = run; }
            const float t1 = __shfl_up(run, 1), t2 = __shfl_up(run, 2), t3 = __shfl_up(run, 3);
            const float off = (part >= 1 ? t1 : 0.f) + (part >= 2 ? t2 : 0.f) + (part >= 3 ? t3 : 0.f);
#pragma unroll
            for (int e = 0; e < 16; ++e) cumL[(part * 16 + e) * 68 + k] = __expf(v[e] + off);
            if (part == 3) lamL[k] = __expf(run + off);
        } else {
            const int t = (tid - 256) >> 2, part = tid & 3;
            float ssq = 0.f, rk = 0.f;
#pragma unroll
            for (int e = 0; e < 16; ++e) {
                const int c = part * 16 + e;
                const float kraw = bf2f(KR[t * 72 + c]), a = bf2f(aL[t * 72 + c]);
                const float kkr = kraw * pkk[c];
                ssq += kkr * kkr;
                rk += bf2f(RR[t * 72 + c]) * kraw * (1.f + (a - 1.f) * pka[c]) * pus[c];
            }
            ssq += __shfl_xor(ssq, 1); ssq += __shfl_xor(ssq, 2); rk += __shfl_xor(rk, 1); rk += __shfl_xor(rk, 2);
            if (part == 0) {
                invn[t] = 1.f / fmaxf(sqrtf(ssq), 1e-12f);
                if (d == 0 && seg != 3) RK[(size_t)hd * M_ROWS + rbase + t] = rk;
            }
        }
        __syncthreads();
        {
            const int t = tid >> 3, c8 = (tid & 7) * 8, tm = t > 0 ? t - 1 : 0;
            typedef const __attribute__((address_space(3))) f32x4_t* lv4;
            float kf[8], rf[8], af[8];
            { const u32x4_t kr = *(const __attribute__((address_space(3))) u32x4_t*)(KR + t * 72 + c8); uint4 k4; k4.x = kr.x; k4.y = kr.y; k4.z = kr.z; k4.w = kr.w; unpack8(k4, kf); }
            { const u32x4_t rr = *(const __attribute__((address_space(3))) u32x4_t*)(RR + t * 72 + c8); uint4 r4; r4.x = rr.x; r4.y = rr.y; r4.z = rr.z; r4.w = rr.w; unpack8(r4, rf); }
            { const u32x4_t ar = *(const __attribute__((address_space(3))) u32x4_t*)(aL + t * 72 + c8); uint4 a4; a4.x = ar.x; a4.y = ar.y; a4.z = ar.z; a4.w = ar.w; unpack8(a4, af); }
            const f32x4_t Ev[2] = { *(lv4)(cumL + t * 68 + c8), *(lv4)(cumL + t * 68 + c8 + 4) };
            f32x4_t Pv[2] = { *(lv4)(cumL + tm * 68 + c8), *(lv4)(cumL + tm * 68 + c8 + 4) };
            if (t == 0) { Pv[0] = (f32x4_t){1.f, 1.f, 1.f, 1.f}; Pv[1] = Pv[0]; }
            const f32x4_t Lv[2] = { *(lv4)(lamL + c8), *(lv4)(lamL + c8 + 4) };
            const f32x4_t Kv[2] = { *(lv4)(pkk + c8), *(lv4)(pkk + c8 + 4) };
            const f32x4_t Av[2] = { *(lv4)(pka + c8), *(lv4)(pka + c8 + 4) };
            const float in = invn[t];
            float oq[8], ok[8], oa[8], orr[8], okh[8], oah[8];
#pragma unroll
            for (int e = 0; e < 8; ++e) {
                const float a = af[e], E = Ev[e >> 2][e & 3], em = __builtin_amdgcn_rcpf(E);
                const float kk = kf[e] * Kv[e >> 2][e & 3] * in, ka = kk * a, kb = kf[e] * (1.f + (a - 1.f) * Av[e >> 2][e & 3]);
                oq[e] = kk * Pv[e >> 2][e & 3]; ok[e] = kb * em; oa[e] = ka * em; orr[e] = rf[e] * E;
                const float ee = Lv[e >> 2][e & 3] * em;
                okh[e] = kb * ee; oah[e] = -ka * ee;
            }
            st16_lds(KHT + t * 72 + c8, pack8(okh)); st16_lds(AHT + t * 72 + c8, pack8(oah));
            st16_lds(KQ + t * 88 + c8, pack8(oq)); st16_lds(SA + t * 88 + c8, pack8(ok)); st16_lds(SB + t * 72 + c8, pack8(oa)); st16_lds(RT + t * 72 + c8, pack8(orr));
        }
        __syncthreads();
        {
            const int tt = wave >> 1;
#pragma unroll
            for (int m = 0; m < 4; ++m)
#pragma unroll
                for (int i = 0; i < 2; ++i) {
                    const int ts = 2 * (wave & 1) + i;
                    f32x4_t acc = (f32x4_t){0.f, 0.f, 0.f, 0.f};
                    if (ts <= tt && !(seg == 3 && (m & 1))) {
                        const lbf16* Aop = (m == 0 || m == 2) ? (SB + ts * 16 * 72) : (SA + ts * 16 * 88);
                        const int lda = (m == 0 || m == 2) ? 72 : 88;
                        const lbf16* Bop = (m < 2) ? (KQ + tt * 16 * 88) : (RT + tt * 16 * 72);
                        const int ldb = (m < 2) ? 88 : 72;
                        acc = mma16<64>(acc, Aop, lda, Bop, ldb, lane);
                    }
                    const int t = 16 * tt + l15, sb = 16 * ts + q4;
#pragma unroll
                    for (int r = 0; r < 4; ++r) { const bool keep = (m < 2) ? (sb + r < t) : (sb + r <= t); acc[r] = keep ? acc[r] : 0.f; }
                    if (m == 0) {
                        if (ts == tt) { *(__attribute__((address_space(3))) f32x4_t*)(NdL + (tt * 16 + l15) * 16 + q4) = acc; acc = (f32x4_t){0.f, 0.f, 0.f, 0.f}; }
                        st4_bf16(RR + t * 72 + sb, -acc);
                    } else if (m == 1) st4_bf16(KR + t * 72 + sb, acc);
                    else if (m == 2) st4_bf16(BRA + t * 72 + sb, -acc);
                    else st4_bf16(BRK + t * 72 + sb, acc);
                }
        }
        __syncthreads();
        f32x4_t rhs[2];
        {
            const int tv = wave & 3;
#pragma unroll
            for (int i = 0; i < 2; ++i) {
                const int tt = 2 * (wave >> 2) + i;
                f32x4_t acc = (f32x4_t){0.f, 0.f, 0.f, 0.f};
                acc = mma16<64>(acc, KQ + tt * 16 * 88, 88, SBF + tv * 16 * 72, 72, lane);
                if (seg != 3) acc = mma16_tB<64>(acc, KR + tt * 16 * 72, 72, VT, 72, 16 * tv, lane);
                rhs[i] = acc;
            }
            if (wave == 0) {
                const int b = lane >> 4, j = lane & 15;
                const lf32* N = NdL + b * 256;
                float Tc[16];
                Tc[0] = (j == 0) ? 1.f : 0.f;
#define RW_INV_ROWS(lo, hi) do { f32x4_t Nr_[(hi) - (lo) + 1][4]; \
                    _Pragma("unroll") for (int i_ = (lo); i_ <= (hi); ++i_) _Pragma("unroll") for (int q_ = 0; q_ <= (i_ - 1) >> 2; ++q_) Nr_[i_ - (lo)][q_] = *(const __attribute__((address_space(3))) f32x4_t*)(N + i_ * 16 + 4 * q_); \
                    __builtin_amdgcn_sched_barrier(0); \
                    _Pragma("unroll") for (int i_ = (lo); i_ <= (hi); ++i_) { float acc_ = (i_ == j) ? 1.f : 0.f; \
                        _Pragma("unroll") for (int m_ = 0; m_ < i_; ++m_) acc_ -= Nr_[i_ - (lo)][m_ >> 2][m_ & 3] * Tc[m_]; \
                        Tc[i_] = acc_; } } while (0)
                RW_INV_ROWS(1, 6); RW_INV_ROWS(7, 9); RW_INV_ROWS(10, 11); RW_INV_ROWS(12, 13); RW_INV_ROWS(14, 15);
                float t0[8], t1[8];
#pragma unroll
                for (int i = 0; i < 8; ++i) { t0[i] = Tc[i]; t1[i] = Tc[8 + i]; }
                st16_lds(TBT + (b * 32 + j) * 24, pack8(t0)); st16_lds(TBT + (b * 32 + j) * 24 + 8, pack8(t1));
            }
        }
        __syncthreads();
        { const int nstep = step + 1 < st_hi ? step + 1 : step; RW_LOADP(nstep); }
#pragma unroll
        for (int b = 0; b < 4; ++b) {
            const int tv = wave & 3;
            if ((wave >> 2) == (b >> 1)) {
                f32x4_t x = mma16<64>(rhs[b & 1], RR + b * 16 * 72, 72, UT + tv * 16 * 88, 88, lane);
                st4_bf16(SA + (16 * tv + l15) * 88 + 16 * b + q4, x);
            }
            __syncthreads();
            if ((wave >> 2) == (b >> 1)) {
                f32x4_t ub = (f32x4_t){0.f, 0.f, 0.f, 0.f};
                ub = mma16_tA<32>(ub, TBT + b * 32 * 24, 24, 0, SA + tv * 16 * 88 + 16 * b, 88, lane);
                st4_bf16(UT + (16 * tv + l15) * 88 + 16 * b + q4, ub);
            }
            __syncthreads();
        }
        {
            const int tt = wave >> 1;
#pragma unroll
            for (int i = 0; i < 2; ++i) {
                const int tv = 2 * (wave & 1) + i;
                f32x4_t acc = (f32x4_t){0.f, 0.f, 0.f, 0.f};
                acc = mma16<64>(acc, SBF + tv * 16 * 72, 72, RT + tt * 16 * 72, 72, lane);
                if (seg != 3) acc = mma16_tA<64>(acc, VT, 72, 16 * tv, BRK + tt * 16 * 72, 72, lane);
                acc = mma16<64>(acc, UT + tv * 16 * 88, 88, BRA + tt * 16 * 72, 72, lane);
                const int t = 16 * tt + l15;
                const size_t row = (size_t)(rbase + (d ? 63 - t : t));
                uint2 w; w.x = pg8::cvt_pk_bf16(acc[0], acc[1]); w.y = pg8::cvt_pk_bf16(acc[2], acc[3]);
                if (seg == 3) *(uint2*)(ZB + ((size_t)(d * 8 + hd) * 4096 + zrow_of(sid, d, (int)row)) * 64 + 16 * tv + q4) = w;
                else *(uint2*)(YBD + row * 64 + 16 * tv + q4) = w;
            }
#pragma unroll
            for (int i = 0; i < 2; ++i) {
                const int tk = 2 * (wave & 1) + i;
                f32x4_t acc = S[i];
#pragma unroll
                for (int r = 0; r < 4; ++r) acc[r] *= lamL[16 * tk + q4 + r];
                if (seg != 3) acc = mma16_tAB<64>(acc, KHT, 72, 16 * tk, VT, 72, 16 * s_tv, lane);
                acc = mma16_tA<64>(acc, AHT, 72, 16 * tk, UT + s_tv * 16 * 88, 88, lane);
                S[i] = acc;
            }
        }
        __syncthreads();
    }
    if (seg == 1) {
#pragma unroll
        for (int i = 0; i < 2; ++i) {
            const int tk = 2 * (wave & 1) + i;
            *(f32x4_t*)(SMID + ((size_t)((sid - 32) * 2 + d) * 8 + hd) * 4096 + (size_t)(16 * s_tv + l15) * 64 + 16 * tk + q4) = S[i];
        }
    }
    if (sid < 32) {
#pragma unroll
        for (int i = 0; i < 2; ++i) {
            const int tk = 2 * (wave & 1) + i;
            *(f32x4_t*)(out_s + ((size_t)(sid * 2 + d) * 8 + hd) * 4096 + (size_t)(16 * s_tv + l15) * 64 + 16 * tk + q4) = S[i];
        }
    }
}

constexpr int CB_GL = 0, CB_BT = 17408, CB_G = 17408 + 2 * 17408, CB_END = CB_G + 64 * 520 * 2;
constexpr int CB_FXA = 0, CB_FXB = CB_END, CB_SB = CB_END + 16384, CB_ZC = CB_SB + 9216;
DEV void phase_even_combine_t(const bf16_t* P, const bf16_t* HAD, const bf16_t* HAD2, const bf16_t* YBD, const float* SMID, const bf16_t* ZB, const float* RK, const float* a_norm_w, const bf16_t* GUPT,
                              const float* ln_w, const float* ln_b, bf16_t* Y, unsigned char* lds_, int tid, int blk, int G) {
    lbf16* GLt = (lbf16*)(lds_ + CB_GL); lbf16* Bt = (lbf16*)(lds_ + CB_BT); lbf16* Gl = (lbf16*)(lds_ + CB_G);
    const int lane = tid & 63, wave = tid >> 6, q4 = (lane >> 4) * 4, l15 = lane & 15;
    for (int tile = blk; tile < M_ROWS / 64; tile += G) {
        const int r0 = tile * 64;
        __syncthreads();
        {
            const int j = tid >> 3, c16 = (tid & 7) * 16;
            const bf16_t* src = P + (size_t)(r0 + j) * PLD + 2064 + 1728 + c16;
#pragma unroll
            for (int hh = 0; hh < 2; ++hh) {
                float f[8]; unpack8(*(const uint4*)(src + 8 * hh), f);
#pragma unroll
                for (int e = 0; e < 8; ++e) f[e] = sigmoidf_(f[e]);
                st16_lds(GLt + j * 136 + c16 + 8 * hh, pack8(f));
            }
        }
        for (int cc = 0; cc < 8; ++cc) {
            lbf16* Bc = Bt + (cc & 1) * (64 * 136);
            {
                const int c = tid >> 3, i16 = (tid & 7) * 16;
                const bf16_t* src = GUPT + (size_t)(cc * 64 + c) * 128 + i16;
                st16_lds(Bc + c * 136 + i16, *(const uint4*)src); st16_lds(Bc + c * 136 + i16 + 8, *(const uint4*)(src + 8));
            }
            __syncthreads();
            const int tt = wave >> 1, tc0 = 2 * (wave & 1);
            f32x4_t a0 = (f32x4_t){0.f, 0.f, 0.f, 0.f}, a1 = a0;
            mma16_2A<128>(a0, a1, Bc + tc0 * 16 * 136, Bc + (tc0 + 1) * 16 * 136, 136, GLt + tt * 16 * 136, 136, lane);
            st4_bf16(Gl + (16 * tt + l15) * 520 + cc * 64 + 16 * tc0 + q4, a0);
            st4_bf16(Gl + (16 * tt + l15) * 520 + cc * 64 + 16 * (tc0 + 1) + q4, a1);
        }
        __syncthreads();
        const bool lat_t = r0 >= 8192 && G >= 160;
        lbf16* FXA = (lbf16*)(lds_ + CB_FXA); lbf16* FXB = (lbf16*)(lds_ + CB_FXB);
        if (lat_t) {
            lbf16* Sb = (lbf16*)(lds_ + CB_SB); lbf16* Zc = (lbf16*)(lds_ + CB_ZC);
            const int sq = (r0 - 8192) >> 12, dd = ((((r0 - 8192) & 4095) >> 6) >= 32) ? 0 : 1;
            const int j = tid >> 3, c8 = (tid & 7) * 8;
            const size_t zoff = ((size_t)(dd * 8) * 4096 + zrow_of(32 + sq, dd, r0 + j)) * 64 + c8;
            const float* sp0 = SMID + ((size_t)(sq * 2 + dd) * 8) * 4096 + j * 64 + c8;
            float4 sa = *(const float4*)sp0, sb4 = *(const float4*)(sp0 + 4); uint4 zq = *(const uint4*)(ZB + zoff);
            for (int hd = 0; hd < 8; ++hd) {
                { float f[8] = {sa.x, sa.y, sa.z, sa.w, sb4.x, sb4.y, sb4.z, sb4.w}; st16_lds(Sb + j * 72 + c8, pack8(f)); st16_lds(Zc + j * 72 + c8, zq); }
                __syncthreads();
                { const int hn = hd < 7 ? hd + 1 : hd; const float* sp = sp0 + (size_t)hn * 4096; sa = *(const float4*)sp; sb4 = *(const float4*)(sp + 4); zq = *(const uint4*)(ZB + zoff + (size_t)hn * 4096 * 64); }
                const int tt = wave >> 1;
#pragma unroll
                for (int i = 0; i < 2; ++i) {
                    const int tv = 2 * (wave & 1) + i;
                    f32x4_t acc = (f32x4_t){0.f, 0.f, 0.f, 0.f};
                    acc = mma16<64>(acc, Sb + tv * 16 * 72, 72, Zc + tt * 16 * 72, 72, lane);
                    lbf16* dst = hd < 6 ? FXA + (16 * tt + l15) * 384 + hd * 64 + 16 * tv + q4 : FXB + (16 * tt + l15) * 128 + (hd - 6) * 64 + 16 * tv + q4;
                    st4_bf16(dst, acc);
                }
                __syncthreads();
            }
        }
        for (int rr = 0; rr < 8; ++rr) {
            const int tl = wave * 8 + rr;
            const size_t r = (size_t)(r0 + tl);
            const int c0 = lane * 8;
            {
                float x[8]; float sacc = 0.f;
                {
                    const int hh = c0 >> 7, cc = c0 & 127, vq = cc >> 5, c5 = cc & 31;
                    float f0[8], f1[8];
                    unpack8(*(const uint4*)(had_slab(HAD, HAD2, (0 * 4 + vq) * 4 + hh) + r * 32 + c5), f0);
                    unpack8(*(const uint4*)(had_slab(HAD, HAD2, (1 * 4 + vq) * 4 + hh) + r * 32 + c5), f1);
#pragma unroll
                    for (int e = 0; e < 8; ++e) { x[e] = f0[e] + f1[e]; sacc += x[e]; }
                }
#pragma unroll
                for (int o = 1; o < 16; o <<= 1) sacc += __shfl_xor(sacc, o);
                const float mean = sacc * (1.f / 128.f);
                float q = 0.f;
#pragma unroll
                for (int e = 0; e < 8; ++e) { x[e] -= mean; q += x[e] * x[e]; }
#pragma unroll
                for (int o = 1; o < 16; o <<= 1) q += __shfl_xor(q, o);
                const float rs = rsqrtf(q * (1.f / 128.f) + 1e-6f);
                float ao[8]; unpack8(*(const uint4*)(P + r * PLD + 1536 + c0), ao);
                float y[8];
#pragma unroll
                for (int e = 0; e < 8; ++e) y[e] = x[e] * rs * a_norm_w[c0 + e] * sigmoidf_(ao[e]);
                *(uint4*)(Y + r * 1024 + c0) = pack8(y);
            }
            {
                float x[8]; float sacc = 0.f;
                const int hd = c0 >> 6, c6 = c0 & 63;
                {
                    float f0[8], f1[8];
                    unpack8(*(const uint4*)(YBD + ((size_t)(0 * 8 + hd) * M_ROWS + r) * 64 + c6), f0);
                    unpack8(*(const uint4*)(YBD + ((size_t)(1 * 8 + hd) * M_ROWS + r) * 64 + c6), f1);
                    if (lat_t) {
                        float fx[8]; const lbf16* fp = hd < 6 ? FXA + tl * 384 + c0 : FXB + tl * 128 + (c0 - 384);
                        { const u32x4_t fr4 = *(const __attribute__((address_space(3))) u32x4_t*)fp; uint4 f4; f4.x = fr4.x; f4.y = fr4.y; f4.z = fr4.z; f4.w = fr4.w; unpack8(f4, fx); }
#pragma unroll
                        for (int e = 0; e < 8; ++e) f0[e] += fx[e];
                    }
#pragma unroll
                    for (int e = 0; e < 8; ++e) { x[e] = f0[e] + f1[e]; sacc += x[e]; }
                }
#pragma unroll
                for (int o = 1; o < 8; o <<= 1) sacc += __shfl_xor(sacc, o);
                const float mean = sacc * (1.f / 64.f);
                float q = 0.f;
#pragma unroll
                for (int e = 0; e < 8; ++e) { x[e] -= mean; q += x[e] * x[e]; }
#pragma unroll
                for (int o = 1; o < 8; o <<= 1) q += __shfl_xor(q, o);
                const float rs = rsqrtf(q * (1.f / 64.f) + 64e-5f);
                float g[8];
                { const u32x4_t gr = *(const __attribute__((address_space(3))) u32x4_t*)(Gl + tl * 520 + c0); uint4 g4; g4.x = gr.x; g4.y = gr.y; g4.z = gr.z; g4.w = gr.w; unpack8(g4, g); }
                float vb[8]; unpack8(*(const uint4*)(P + r * PLD + 2064 + 1024 + c0), vb);
                const float rk = RK[(size_t)hd * M_ROWS + r];
                float y[8];
#pragma unroll
                for (int e = 0; e < 8; ++e) y[e] = (x[e] * rs * ln_w[c0 + e] + ln_b[c0 + e] + rk * vb[e]) * g[e];
                *(uint4*)(Y + r * 1024 + 512 + c0) = pack8(y);
            }
        }
    }
}

#define LAS __attribute__((address_space(3)))
#define XB_TMO      128
#define XB_XCNT(j)  (256  + 64 * (j))
#define XB_XSUB(j)  (1280 + 64 * (j))
#define XB_XGEN(j)  (2304 + 64 * (j))
#define XB_TOP      3328
#define XB_TOPGEN   3392
#define XCD_BAR_WORDS 3456
#define XB_SPIN_CAP (1u << 25)
__device__ __forceinline__ unsigned xb_ld(unsigned* p)              { return __hip_atomic_load(p, __ATOMIC_RELAXED, __HIP_MEMORY_SCOPE_AGENT); }
__device__ __forceinline__ unsigned xb_add(unsigned* p, unsigned v) { return __hip_atomic_fetch_add(p, v, __ATOMIC_RELAXED, __HIP_MEMORY_SCOPE_AGENT); }
__device__ __forceinline__ unsigned xb_xcc_id() { return (unsigned)__builtin_amdgcn_s_getreg((3 << 11) | 20) & 0xFu; }
#define XB_SPIN(cond, bar) do { unsigned _sp = 0; while (cond) { __builtin_amdgcn_s_sleep(1); \
    if ((++_sp & 255u) == 0u) { if (xb_ld(&(bar)[XB_TMO])) break; if (_sp > XB_SPIN_CAP) { atomicAdd(&(bar)[XB_TMO], 1u); break; } } } } while (0)
struct XcdBarrier { unsigned* bar; unsigned x; volatile LAS unsigned* st; };
__device__ __forceinline__ XcdBarrier xcd_barrier_post(unsigned* bar, volatile LAS unsigned* st) {
    XcdBarrier b; b.bar = bar; b.x = xb_xcc_id(); b.st = st;
    if (threadIdx.x == 0) (void)xb_add(&bar[XB_XCNT(b.x)], 1u);
    return b;
}
__device__ __forceinline__ void xcd_barrier_complete(unsigned* bar, unsigned x, unsigned& nloc, unsigned& nx) {
    const unsigned G = gridDim.x * gridDim.y * gridDim.z;
    unsigned sum, cnt, mine, sp = 0u;
    for (;;) {
        sum = 0u; cnt = 0u; mine = 0u;
#pragma unroll
        for (unsigned j = 0; j < 16; ++j) { const unsigned c = xb_ld(&bar[XB_XCNT(j)]); sum += c; cnt += (c > 0u) ? 1u : 0u; mine = (j == x) ? c : mine; }
        if (sum == G) break;
        __builtin_amdgcn_s_sleep(1);
        if ((++sp & 255u) == 0u) { if (xb_ld(&bar[XB_TMO])) break; if (sp > XB_SPIN_CAP) { atomicAdd(&bar[XB_TMO], 1u); break; } }
    }
    nloc = mine > 0u ? mine : 1u; nx = cnt > 0u ? cnt : 1u;
}
__device__ __forceinline__ void xcd_barrier(const XcdBarrier& b) {
    asm volatile("s_waitcnt vmcnt(0)" ::: "memory");
    __syncthreads();
    if (threadIdx.x == 0) {
        unsigned* bar = b.bar;
        __builtin_amdgcn_s_waitcnt(0);
        unsigned nloc = b.st[0], nx = b.st[1];
        if (nloc == 0u) { xcd_barrier_complete(bar, b.x, nloc, nx); b.st[0] = nloc; b.st[1] = nx; }
        const unsigned old = xb_add(&bar[XB_XSUB(b.x)], 1u);
        const unsigned gen = old / nloc;
        if (old + 1u == (gen + 1u) * nloc) {
            __builtin_amdgcn_fence(__ATOMIC_RELEASE, "agent");
            asm volatile("s_waitcnt vmcnt(0)" ::: "memory");
            const unsigned og = xb_add(&bar[XB_TOP], 1u);
            const unsigned tg = og / nx;
            if (og + 1u == (tg + 1u) * nx) xb_add(&bar[XB_TOPGEN], 1u);
            else XB_SPIN(xb_ld(&bar[XB_TOPGEN]) == tg, bar);
            __builtin_amdgcn_fence(__ATOMIC_ACQUIRE, "agent");
            xb_add(&bar[XB_XGEN(b.x)], 1u);
            asm volatile("s_waitcnt vmcnt(0)" ::: "memory");
        } else {
            XB_SPIN(xb_ld(&bar[XB_XGEN(b.x)]) == gen, bar);
            __builtin_amdgcn_fence(__ATOMIC_ACQUIRE, "agent");
            asm volatile("s_waitcnt vmcnt(0)" ::: "memory");
        }
    }
    __syncthreads();
}

constexpr int LDS_BYTES = 163840;
constexpr int LDS_MISC = 163328;
struct MegaArgs { const float* in[40]; float* out; unsigned char* ws; ConvArgs ca, cb, cc, cd, ce; };

__global__ void __launch_bounds__(512, 2) mega_fwd(MegaArgs a) {
    extern __shared__ __attribute__((aligned(16))) unsigned char lds[];
    const int G = (int)gridDim.x, blk = (int)blockIdx.x, ngw = G * 8;
    if (G != 256) { if (threadIdx.x == 0) a.out[(size_t)blk * 1024] = __builtin_nanf(""); return; }
#define TIDX() int tid = threadIdx.x; asm volatile("" : "+v"(tid)); const int lane = tid & 63, wave = __builtin_amdgcn_readfirstlane(tid >> 6), gw = blk * 8 + wave; (void)lane; (void)gw
    { TIDX(); for (int u = tid; u < (LDS_BYTES - LDS_MISC) / 4; u += 512) ((unsigned*)(lds + LDS_MISC))[u] = 0u; }
    __syncthreads();
    unsigned char* ws = a.ws;
    const size_t MiB = 1u << 20;
    XcdBarrier bar = xcd_barrier_post((unsigned*)ws, (volatile LAS unsigned*)(lds + LDS_MISC));
#define GRID_BAR() xcd_barrier(bar)
#define PANEL_WAIT(ctr) do { if (threadIdx.x == 0) { unsigned* c_ = (ctr) + (8 * (blk & 7) + ((blk >> 3) & 7));     \
        XB_SPIN(xb_ld(c_) < 4u, bar.bar); __builtin_amdgcn_fence(__ATOMIC_ACQUIRE, "agent"); asm volatile("s_waitcnt vmcnt(0)" ::: "memory"); } __syncthreads(); } while (0)

    const float* x_prompt = a.in[0]; const float* x_sample = a.in[1];
    const float* st_c = a.in[2]; const float* st_n = a.in[3]; const float* st_m = a.in[4]; const float* st_rwkv = a.in[5]; const float* st_ssd = a.in[6];
    const float* c = a.in[7]; const float* c_ctx = a.in[8]; const float* mod_w = a.in[9]; const float* mod_b = a.in[10]; const float* norm_w = a.in[11];
    const float* ev_a_conv_w = a.in[15]; const float* ev_a_conv_b = a.in[16]; const float* ev_a_gate_b = a.in[17]; const float* ev_a_norm_w = a.in[18];
    const float* ev_b_mu = a.in[19]; const float* ev_b_w0 = a.in[20]; const float* ev_b_w_up = a.in[21]; const float* ev_b_a0 = a.in[22]; const float* ev_b_a_up = a.in[23];
    const float* ev_b_g_up = a.in[24]; const float* ev_b_k_k = a.in[25]; const float* ev_b_k_a = a.in[26]; const float* ev_b_u = a.in[27];
    const float* ev_b_ln_w = a.in[28]; const float* ev_b_ln_b = a.in[29];
    const float* od_conv_w = a.in[32]; const float* od_conv_b = a.in[33]; const float* od_dt_bias = a.in[34]; const float* od_a_log = a.in[35]; const float* od_d = a.in[36];
    const float* final_norm_w = a.in[39];

    float* out = a.out;
    float* OUT = out;
    bf16_t* XB = (bf16_t*)(ws + 10 * MiB);
    float* o_mc = out + 16777216; float* o_mn = o_mc + 4194304; float* o_mm = o_mn + 32768; float* o_rw = o_mm + 256; float* o_ssd = o_rw + 2097152;
    unsigned char* wa = (unsigned char*)o_ssd;
    bf16_t* Wev_in = (bf16_t*)(wa); bf16_t* Wev_out = (bf16_t*)(wa + 8 * MiB); bf16_t* Wffn_in0 = (bf16_t*)(wa + 10 * MiB);
    bf16_t* Wffn_out0 = (bf16_t*)(wa + 21 * MiB); bf16_t* Wod_xbc = (bf16_t*)(wa + 27 * MiB);
    float* MODS = (float*)(ws + 1 * MiB); float* ROWSS = (float*)(ws + 1 * MiB + 512 * 1024); bf16_t* GUPT = (bf16_t*)(ws + 254 * MiB + 512 * 1024); bf16_t* UPT = (bf16_t*)(ws + 1 * MiB + 768 * 1024);
    float* TPOS = (float*)(ws + 246 * MiB); float* RS4 = (float*)(ws + 255 * MiB); unsigned* NCNT = (unsigned*)ws + 3584; unsigned* PDONE = (unsigned*)ws + 3904; unsigned* CVDONE = (unsigned*)ws + 3872;     unsigned* TMOW = (unsigned*)ws + XB_TMO; bf16_t* HB = (bf16_t*)(ws + 202 * MiB); bf16_t* YS2 = (bf16_t*)(a.out + 8388608); bf16_t* YBD2 = (bf16_t*)(a.out + 8388608);
    bf16_t* Wod_z = (bf16_t*)(ws + 2 * MiB); float* SIDE = (float*)(ws + 6 * MiB); bf16_t* H = (bf16_t*)out;
    bf16_t* P = (bf16_t*)(ws + 42 * MiB); bf16_t* Yev = (bf16_t*)(ws + 170 * MiB); bf16_t* HAD = (bf16_t*)(wa + 36 * MiB); bf16_t* HAD2 = (bf16_t*)(ws + 235 * MiB); bf16_t* YBD = (bf16_t*)(ws + 202 * MiB); float* RK = (float*)(ws + 234 * MiB); float* SMID = (float*)(ws + 234 * MiB + 524288); bf16_t* ZB = (bf16_t*)(ws + 240 * MiB);
    bf16_t* ACT0 = (bf16_t*)(ws + 42 * MiB);
    bf16_t* P2a = (bf16_t*)(ws + 42 * MiB); bf16_t* YS = (bf16_t*)(ws + 178 * MiB); float* HALO2 = (float*)(ws + 250 * MiB);     bf16_t* Y2 = (bf16_t*)(ws + 64 * MiB);
    bf16_t* Wod_out = (bf16_t*)(ws + 242 * MiB); bf16_t* Wffn_in1 = (bf16_t*)(ws + 46 * MiB); bf16_t* Wffn_out1 = (bf16_t*)(ws + 246 * MiB); bf16_t* ACT1 = (bf16_t*)(ws + 128 * MiB);
    const float* mods0 = MODS; const float* mods1 = MODS + 3 * 6144;
    PG8_LAS unsigned char* glds = (PG8_LAS unsigned char*)lds;

    { TIDX();
    conv_all(a.ca, (float*)lds + wave * (64 * 33), gw, ngw, lane);
    __syncthreads();
    phase_mods(c, c_ctx, mod_w, mod_b, MODS, lds, tid, blk, G);
    for (int i = blk * 512 + tid; i < M_ROWS; i += G * 512) { ROWSS[i] = 0.f; RS4[i] = 0.f; RS4[M_ROWS + i] = 0.f; RS4[2 * M_ROWS + i] = 0.f; RS4[3 * M_ROWS + i] = 0.f; }
    for (int i = blk * 512 + tid; i < 64 * 512; i += G * 512) {
        const int pos = i >> 9, jj = i & 511, ii = jj & 255;
        const float arg = (float)pos * expf(-9.210340371976184f * (float)ii / 256.f);
        TPOS[i] = (jj & 256) ? cosf(arg) : sinf(arg);
    }
    for (int i = blk * 512 + tid; i < 512 * 128; i += G * 512) GUPT[i] = f2bf(ev_b_g_up[(size_t)(i & 127) * 512 + (i >> 7)]);
    for (int i = blk * 512 + tid; i < 24 * 4096; i += G * 512) {
        const int tb = i >> 12, cc = (i >> 6) & 63, ii = i & 63;
        const float wv = tb < 8 ? ev_b_a_up[(size_t)ii * 512 + 64 * tb + cc] : ev_b_w_up[(size_t)(((tb - 8) >> 3) * 64 + ii) * 512 + 64 * ((tb - 8) & 7) + cc];
        UPT[i] = f2bf(wv);
    } }
    GRID_BAR();
    { TIDX(); phase_embed_norm(x_prompt, x_sample, TPOS, XB, norm_w + 0, mods0, 0, 1, H, gw, ngw, lane); }
    GRID_BAR();
    { TIDX(); stage_mix_weights(lds, 4096, 0, 1024, ev_a_conv_w, ev_a_conv_b, 2064, 1856, ev_b_mu, tid, blk, G); }
    { pg8::StaticOrder S; S.init(M_ROWS, 4096, G, blk);
      pg8::gemm_phase<pg8::EpiProjMix, pg8::StaticOrder, true, true>(glds, pg8::Gemm{H, Wev_in, M_ROWS, 4096, 1024}, S,
          pg8::EpiProjMix{P, PLD, SIDE, 2048, 16, HALO2, 0, 1024, ev_a_conv_w, ev_a_conv_b, 2064, 1856, ev_b_mu, (PG8_LAS float*)(glds + pg8::STAGE_BYTES)}); }
    GRID_BAR();
    { TIDX(); phase_mix_edges(P, PLD, HALO2, 0, 1024, ev_a_conv_w, ev_a_conv_b, 2064, 1856, ev_b_mu, tid, blk, G); }
    GRID_BAR();
    {
        unsigned* qctr = (unsigned*)(ws + 15360);
        volatile unsigned* qslot = (volatile unsigned*)(lds + LDS_MISC + 64);
        if (G >= 160) {
            if (blk < 96) {
                TIDX(); const int seg = 1 + blk / 32, idx = blk & 31, rem = idx & 15;
                job_rwkv_chunked(32 + (idx >> 4), rem >> 1, rem & 1, seg, lds, tid, P, ev_b_w0, UPT, ev_b_a0, ev_b_k_k, ev_b_k_a, ev_b_u, st_rwkv, YBD, RK, o_rw, SMID, ZB);
            } else if (blk < 160) {
                TIDX(); const int j = blk - 96, rem = j & 31;
                job_mlstm_chunked<1>(32 + (j >> 5), rem >> 3, (rem >> 1) & 3, rem & 1, lds, tid, P, SIDE, ev_a_gate_b, st_c, st_n, st_m, HAD, HAD2, o_mc, o_mn, o_mm);
            }
        }
        const int nlat = (G >= 160) ? 0 : 96;
        for (;;) {
            __syncthreads();
            if (threadIdx.x == 0) *qslot = atomicAdd(qctr, 1u);
            __syncthreads();
            const int q = (int)*qslot;
            if (q >= 1024 + nlat) break;
            TIDX();
            if (q < nlat) {
                if (q < 32) { const int rem = q & 15; job_rwkv_chunked(32 + (q >> 4), rem >> 1, rem & 1, 0, lds, tid, P, ev_b_w0, UPT, ev_b_a0, ev_b_k_k, ev_b_k_a, ev_b_u, st_rwkv, YBD, RK, o_rw, SMID, ZB); }
                else { const int j = q - 32, rem = j & 31; job_mlstm_chunked<1>(32 + (j >> 5), rem >> 3, (rem >> 1) & 3, rem & 1, lds, tid, P, SIDE, ev_a_gate_b, st_c, st_n, st_m, HAD, HAD2, o_mc, o_mn, o_mm); }
            } else {
                const int p = q - nlat;
                if (p < 512) { const int rem = p & 15; job_rwkv_chunked(p >> 4, rem >> 1, rem & 1, 0, lds, tid, P, ev_b_w0, UPT, ev_b_a0, ev_b_k_k, ev_b_k_a, ev_b_u, st_rwkv, YBD, RK, o_rw, SMID, ZB); }
                else { const int jj = p - 512, rem = jj & 15; job_mlstm_chunked<2>(jj >> 4, rem >> 2, (rem >> 1) & 1, rem & 1, lds, tid, P, SIDE, ev_a_gate_b, st_c, st_n, st_m, HAD, HAD2, o_mc, o_mn, o_mm); }
            }
        }
    }
    GRID_BAR();
    { TIDX(); phase_even_combine_t(P, HAD, HAD2, YBD, SMID, ZB, RK, ev_a_norm_w, GUPT, ev_b_ln_w, ev_b_ln_b, Yev, lds, tid, blk, G);
      __syncthreads();
      if (blk < 128) conv_all(a.cc, (float*)lds + wave * (64 * 33), blk * 8 + wave, 128 * 8, lane); }
    GRID_BAR();
    { pg8::StaticOrder S; S.init(M_ROWS, 1024, G, blk);
      pg8::gemm_phase<pg8::EpiResidNorm, pg8::StaticOrder, true, true>(glds, pg8::Gemm{Yev, Wev_out, M_ROWS, 1024, 1024}, S,
          pg8::EpiResidNorm{XB, OUT, mods0 + 2 * 1024, nullptr, 0.f, RS4, NCNT, TMOW, norm_w + 1024, mods0, 3, 4, HB, PDONE}); }
    PANEL_WAIT(PDONE);
    { pg8::StaticOrder S; S.init(M_ROWS, 2 * FFN_H, G, blk);
      pg8::gemm_phase<pg8::EpiSwiGLU, pg8::StaticOrder, true, true>(glds, pg8::Gemm{HB, Wffn_in0, M_ROWS, 2 * FFN_H, 1024}, S, pg8::EpiSwiGLU{ACT0, FFN_H, true}); }
    if (blk >= 128) { TIDX(); conv_all(a.cd, (float*)lds + wave * (64 * 33), (blk - 128) * 8 + wave, 128 * 8, lane, true); }
    asm volatile("s_waitcnt vmcnt(0)" ::: "memory");
    __syncthreads();
    if (threadIdx.x == 0) { (void)xb_add(PDONE + 128 + (8 * (blk & 7) + ((blk >> 3) & 7)), 1u); if (blk >= 128) (void)xb_add(CVDONE, 1u);
        XB_SPIN(xb_ld(CVDONE) < 128u, bar.bar); }
    PANEL_WAIT(PDONE + 128);
    { pg8::StaticOrder S; S.init(M_ROWS, 1024, G, blk);
      pg8::gemm_phase<pg8::EpiResidNorm, pg8::StaticOrder, true, true>(glds, pg8::Gemm{ACT0, Wffn_out0, M_ROWS, 1024, FFN_H}, S,
          pg8::EpiResidNorm{XB, OUT, mods0 + 5 * 1024, nullptr, 0.f, RS4 + M_ROWS, NCNT + 64, TMOW, norm_w + 2048, mods1, 0, 1, H, nullptr}); }
    GRID_BAR();
    { TIDX(); stage_mix_weights(lds, 4096, 0, 4096, od_conv_w, od_conv_b, 0, 0, od_conv_w, tid, blk, G); }
    { pg8::StaticOrder S; S.init(M_ROWS, 4096, G, blk);
      pg8::gemm_phase<pg8::EpiProjMix, pg8::StaticOrder, true, true>(glds, pg8::Gemm{H, Wod_xbc, M_ROWS, 4096, 1024}, S,
          pg8::EpiProjMix{P2a, P2LD, nullptr, 0, 0, HALO2, 0, 4096, od_conv_w, od_conv_b, 0, 0, od_conv_w, (PG8_LAS float*)(glds + pg8::STAGE_BYTES)}); }
    GRID_BAR();
    { TIDX(); phase_dt(H, Wod_xbc + (size_t)4096 * 1024, SIDE, lds, tid, blk, G);
      phase_mix_edges(P2a, P2LD, HALO2, 0, 4096, od_conv_w, od_conv_b, 0, 0, od_conv_w, tid, blk, G); }
    GRID_BAR();
    {
        TIDX();
        if (G == 256) {
            if (blk < 128) {
                const int x = blk & 7, slot = blk >> 3, set = x * 4 + (slot >> 2), member = slot & 3, dd = set & 1;
                job_ssd_1dir(32 + (set >> 4), ((set >> 1) & 7) * 4 + member, dd, lds, tid, P2a, SIDE, od_dt_bias, od_a_log, od_d, st_ssd, dd ? YS2 : YS, dd ? 8192 : M_ROWS, dd ? 8192 : 0);
                __syncthreads();
            } else {
                const int b2 = blk - 128, x = b2 & 7, slot = b2 >> 3, member = slot & 3;
                for (int k = 0; k < 8; ++k) {
                    const int sg = k * 32 + x * 4 + (slot >> 2);
                    job_ssd_chunked<2>(sg >> 3, (sg & 7) * 4 + member, 0, lds, tid, P2a, SIDE, od_dt_bias, od_a_log, od_d, st_ssd, YS, o_ssd);
                    __syncthreads();
                }
            }
        } else {
            for (int j = blk; j < 2176; j += G) {
                const int jj = j < 128 ? j : j - 128;
                job_ssd_chunked<1>(j < 128 ? 32 + (jj >> 6) : (jj >> 6), (jj >> 1) & 31, jj & 1, lds, tid, P2a, SIDE, od_dt_bias, od_a_log, od_d, st_ssd, YS, o_ssd);
                __syncthreads();
            }
        }
    }
    GRID_BAR();
    { TIDX(); conv_all(a.cb, (float*)lds + wave * (64 * 33), gw, ngw, lane); }
    __syncthreads();
    { pg8::StaticOrder S; S.init(M_ROWS, 2048, G, blk);
      pg8::gemm_phase<pg8::EpiGateZ, pg8::StaticOrder, true, true>(glds, pg8::Gemm{H, Wod_z, M_ROWS, 2048, 1024}, S, pg8::EpiGateZ{YS, Y2, 2048, ROWSS, YS2}); }
    GRID_BAR();
    { pg8::StaticOrder S; S.init(M_ROWS, 1024, G, blk);
      pg8::gemm_phase<pg8::EpiResidNorm, pg8::StaticOrder, true, true>(glds, pg8::Gemm{Y2, Wod_out, M_ROWS, 1024, 2048}, S,
          pg8::EpiResidNorm{XB, OUT, mods1 + 2 * 1024, ROWSS, 1.f / 2048.f, RS4 + 2 * M_ROWS, NCNT + 128, TMOW, norm_w + 3072, mods1, 3, 4, H, PDONE + 64}); }
    PANEL_WAIT(PDONE + 64);
    { pg8::StaticOrder S; S.init(M_ROWS, 2 * FFN_H, G, blk);
      pg8::gemm_phase<pg8::EpiSwiGLU, pg8::StaticOrder, true, true>(glds, pg8::Gemm{H, Wffn_in1, M_ROWS, 2 * FFN_H, 1024}, S, pg8::EpiSwiGLU{ACT1, FFN_H, false}); }
    if (blk >= 128) { TIDX(); conv_all(a.ce, (float*)lds + wave * (64 * 33), (blk - 128) * 8 + wave, 128 * 8, lane); }
    GRID_BAR();
    { pg8::StaticOrder S; S.init(M_ROWS, 1024, G, blk);
      pg8::gemm_phase<pg8::EpiResidNorm, pg8::StaticOrder, true, true>(glds, pg8::Gemm{ACT1, Wffn_out1, M_ROWS, 1024, FFN_H}, S,
          pg8::EpiResidNorm{XB, OUT, mods1 + 5 * 1024, nullptr, 0.f, RS4 + 3 * M_ROWS, NCNT + 192, TMOW, final_norm_w, nullptr, 0, 0, nullptr, nullptr}); }
}

static void add_conv(ConvArgs& a, const float* W, const float* kscale, bf16_t* WT, int ldw, int K, int Ndst, int mode, int c0, int nvalid) {
    ConvJob& j = a.j[a.njobs++];
    j.W = W; j.kscale = kscale; j.WT = WT; j.ldw = ldw; j.K = K; j.Ndst = Ndst; j.mode = mode; j.c0 = c0; j.nvalid = nvalid;
    j.item0 = a.total; j.nitems = (K / 64) * (Ndst / 32); a.total += j.nitems;
}

extern "C" void kernel_launch(void* const* d_in, const int* in_sizes, int n_in, void* d_out, int out_size, void* d_ws, size_t ws_size, hipStream_t stream) {
    static int grid = 0;
    if (grid == 0) {
        int dev = 0, cus = 0;
        if (hipGetDevice(&dev) != hipSuccess || hipDeviceGetAttribute(&cus, hipDeviceAttributeMultiprocessorCount, dev) != hipSuccess) cus = 256;
        (void)hipFuncSetAttribute((const void*)mega_fwd, hipFuncAttributeMaxDynamicSharedMemorySize, LDS_BYTES);
        (void)hipGetLastError();
        grid = (cus <= 0 || cus >= 256) ? 256 : cus;
    }
    MegaArgs a{};
    for (int i = 0; i < 40; ++i) a.in[i] = (const float*)d_in[i];
    a.out = (float*)d_out; a.ws = (unsigned char*)d_ws;
    const float* ffn_w_in = a.in[12]; const float* ffn_w_out = a.in[13]; const float* ev_w_in = a.in[14]; const float* ev_w_out = a.in[30];
    const float* od_w_in = a.in[31]; const float* od_norm_w = a.in[37]; const float* od_w_out = a.in[38];
    unsigned char* ws = (unsigned char*)d_ws;
    const size_t MiB = 1u << 20;
    unsigned char* wa = (unsigned char*)((float*)d_out + 23101696);
    add_conv(a.ca, ev_w_in, nullptr, (bf16_t*)(wa), 3920, 1024, 4096, 0, 0, 3920);
    add_conv(a.ca, ev_w_out, nullptr, (bf16_t*)(wa + 8 * MiB), 1024, 1024, 1024, 0, 0, 1024);
    add_conv(a.cc, ffn_w_in, nullptr, (bf16_t*)(wa + 10 * MiB), 5632, 1024, 5632, 1, 0, 5632);
    add_conv(a.cd, ffn_w_out, nullptr, (bf16_t*)(wa + 21 * MiB), 1024, 2816, 1024, 0, 0, 1024);
    add_conv(a.cd, od_w_in, nullptr, (bf16_t*)(wa + 27 * MiB), 6208, 1024, 4352, 0, 2048, 4160);
    add_conv(a.cd, od_w_in, nullptr, (bf16_t*)(ws + 2 * MiB), 6208, 1024, 2048, 0, 0, 2048);
    add_conv(a.cd, od_w_out, od_norm_w, (bf16_t*)(ws + 242 * MiB), 1024, 2048, 1024, 0, 0, 1024);
    add_conv(a.cb, ffn_w_in + (size_t)1024 * 2 * FFN_H, nullptr, (bf16_t*)(ws + 46 * MiB), 5632, 1024, 5632, 1, 0, 5632);
    add_conv(a.ce, ffn_w_out + (size_t)FFN_H * 1024, nullptr, (bf16_t*)(ws + 246 * MiB), 1024, 2816, 1024, 0, 0, 1024);
    (void)hipMemsetAsync(d_ws, 0, 16384, stream);
    hipLaunchKernelGGL(mega_fwd, dim3(grid), dim3(512), LDS_BYTES, stream, a);
}
```

```cpp
#include <hip/hip_runtime.h>
#include <stdint.h>

typedef unsigned short bf16_t;
#define DEV __device__ __forceinline__

constexpr int M_ROWS = 16384;
constexpr int FFN_H = 2816;

DEV float bf2f(bf16_t v) { return __uint_as_float(((unsigned)v) << 16); }
DEV bf16_t f2bf(float f) { unsigned u = __float_as_uint(f); return (bf16_t)((u + 0x7fffu + ((u >> 16) & 1u)) >> 16); }
DEV float sigmoidf_(float x) { return __builtin_amdgcn_rcpf(1.f + __expf(-x)); }
DEV float siluf_(float x) { return x * __builtin_amdgcn_rcpf(1.f + __expf(-x)); }
DEV float logsigmoidf_(float x) { return fminf(x, 0.f) - log1pf(__expf(-fabsf(x))); }
DEV float softplusf_(float x) { return fmaxf(x, 0.f) + log1pf(__expf(-fabsf(x))); }
DEV float wave_sum(float v) {
#pragma unroll
    for (int o = 32; o > 0; o >>= 1) v += __shfl_xor(v, o);
    return v;
}
DEV float block_sum_256(float v, float* sm) {
    v = wave_sum(v);
    if ((threadIdx.x & 63) == 0) sm[threadIdx.x >> 6] = v;
    __syncthreads();
    float r = sm[0] + sm[1] + sm[2] + sm[3];
    __syncthreads();
    return r;
}
DEV void seq_info(int sid, int& row0, int& T) {
    if (sid < 32) { row0 = sid * 256; T = 256; } else { row0 = 8192 + (sid - 32) * 4096; T = 4096; }
}
DEV int row_cls(int row) { return row < 8192 ? 0 : 1 + ((row - 8192) >> 12); }
DEV void row_tT(int row, int& t, int& T) {
    if (row < 8192) { t = row & 255; T = 256; } else { t = (row - 8192) & 4095; T = 4096; }
}

constexpr int PLD = 4096;
constexpr int P2LD = 4352;
namespace pg8 {
#define PG8_LAS __attribute__((address_space(3)))
typedef unsigned short bf16_t;
typedef short bf16x8 __attribute__((ext_vector_type(8)));
typedef float f32x4 __attribute__((ext_vector_type(4)));
typedef unsigned u32x4 __attribute__((ext_vector_type(4)));
typedef unsigned u32x2 __attribute__((ext_vector_type(2)));
constexpr int BM = 256, BK = 64, HALF = 128, HTB = HALF * BK * 2  , STAGE_BYTES = 8 * HTB, NXCD = 8, WGM = 8;

__host__ __device__ __forceinline__ int lds_byte(int r, int c) { const int st = (r >> 4) * 2 + (c >> 5), rr = r & 15, cc = c & 31, ob = rr * 64 + cc * 2; return st * 1024 + (ob ^ (((ob >> 9) & 1) << 5)); }
__host__ __device__ __forceinline__ void stage_rc(int b, int& R, int& C) { const int st = b / 1024, sb = b % 1024, swz = sb ^ (((sb >> 9) & 1) << 5); R = (st >> 1) * 16 + swz / 64; C = (st & 1) * 32 + (swz % 64) / 2; }
__host__ __device__ __forceinline__ int perm32(int rho) { const int n = rho >> 4, i = rho & 15; return 8 * (i >> 2) + 4 * n + (i & 3); }

struct Unit { int pm, pn; };
struct Gemm { const bf16_t* A; const bf16_t* Bt; int M, N, K; };

struct StaticOrder {
    int nM, nN, nwg, G, c;
    __host__ __device__ void init(int M, int N, int G_, int c_) { nM = M / BM; nN = N / BM; nwg = nM * nN; G = G_; c = c_; }
    __host__ __device__ bool next(int i, Unit& u) const {
        const long L = (long)i * G + c; if (L >= nwg) return false;
        int wgid = (int)L; { const int q = nwg / NXCD, r = nwg % NXCD, xcd = wgid % NXCD, off = wgid / NXCD; wgid = (xcd < r ? xcd * (q + 1) : r * (q + 1) + (xcd - r) * q) + off; }
        const int nig = WGM * nN, gid = wgid / nig, fm = gid * WGM, gsz = (nM - fm) < WGM ? (nM - fm) : WGM;
        u.pm = fm + ((wgid % nig) % gsz); u.pn = (wgid % nig) / gsz; return true;
    }
    __device__ __forceinline__ void a_ready(const Unit&) const {}
    __device__ __forceinline__ void done(const Unit&) const {}
};

typedef __bf16 pk_bf16x2_t __attribute__((ext_vector_type(2)));
typedef float pk_f32x2_t __attribute__((ext_vector_type(2)));
__device__ __forceinline__ unsigned cvt_pk_bf16(float lo, float hi) { const pk_f32x2_t f = {lo, hi}; const pk_bf16x2_t b = __builtin_convertvector(f, pk_bf16x2_t); return __builtin_bit_cast(unsigned, b); }
DEV float pg_silu(float x) { return x * __builtin_amdgcn_rcpf(1.f + __expf(-x)); }
struct EpiProj {
    static constexpr bool PERM = true, AFTER_DRAIN = false;
    bf16_t* O; int ldo; float* side; int side_lo, side_n; bf16_t* halo;
    __device__ __forceinline__ void operator()(const f32x4 (&acc)[2][2][4][2], const Unit& u, int wr, int wc, int fr, int fq) const {
        const int row0 = u.pm * BM + wr * 64 + fr, col0 = u.pn * BM + wc * 32 + 8 * fq;
#pragma unroll
        for (int ai = 0; ai < 2; ++ai)
#pragma unroll
            for (int m = 0; m < 4; ++m) {
                const size_t row = (size_t)(row0 + ai * HALF + m * 16);
#pragma unroll
                for (int bj = 0; bj < 2; ++bj) {
                    const int col = col0 + bj * HALF;
                    const f32x4 v0 = acc[ai][bj][m][0], v1 = acc[ai][bj][m][1];
                    u32x4 w; w.x = cvt_pk_bf16(v0[0], v0[1]); w.y = cvt_pk_bf16(v0[2], v0[3]); w.z = cvt_pk_bf16(v1[0], v1[1]); w.w = cvt_pk_bf16(v1[2], v1[3]);
                    *(u32x4*)(O + row * ldo + col) = w;
                    if (halo && ((m == 0 && fr == 0) || (m == 3 && fr == 15))) *(u32x4*)(halo + ((row >> 6) * 2 + (m == 3 ? 1 : 0)) * ldo + col) = w;
                    if (side && col >= side_lo && col < side_lo + side_n) { float* sp = side + row * side_n + (col - side_lo); *(f32x4*)sp = v0; *(f32x4*)(sp + 4) = v1; }
                }
            }
    }
};
__device__ __forceinline__ float dpp_prev(float v) { return __builtin_bit_cast(float, __builtin_amdgcn_update_dpp(0, __builtin_bit_cast(int, v), 0x121, 0xF, 0xF, false)); }
__device__ __forceinline__ float dpp_next(float v) { return __builtin_bit_cast(float, __builtin_amdgcn_update_dpp(0, __builtin_bit_cast(int, v), 0x12F, 0xF, 0xF, false)); }
struct EpiProjMix {
    static constexpr bool PERM = true, AFTER_DRAIN = false;
    bf16_t* O; int ldo; float* side; int side_lo, side_n; float* halo2;
    int ca_lo, ca_n; const float* cw; const float* cb; int sb_lo, sb_n; const float* mu;
    PG8_LAS float* ex;
    __device__ __forceinline__ void operator()(const f32x4 (&acc)[2][2][4][2], const Unit& u, int wr, int wc, int fr, int fq) const {
        const int row0 = u.pm * BM + wr * 64 + fr, cl = wc * 32 + 8 * fq;
#pragma unroll
        for (int ai = 0; ai < 2; ++ai)
#pragma unroll
            for (int bj = 0; bj < 2; ++bj) {
                PG8_LAS float* e0 = ex + ((ai * 2 + wr) * 2) * 256 + bj * HALF + cl;
                if (fr == 0)  { *(PG8_LAS f32x4*)e0 = acc[ai][bj][0][0]; *(PG8_LAS f32x4*)(e0 + 4) = acc[ai][bj][0][1]; }
                if (fr == 15) { *(PG8_LAS f32x4*)(e0 + 256) = acc[ai][bj][3][0]; *(PG8_LAS f32x4*)(e0 + 260) = acc[ai][bj][3][1]; }
            }
        if (halo2 && u.pm >= 32) {
            float* hb = halo2 + (size_t)(u.pm - 32) * 4 * 4096 + u.pn * BM + cl;
#pragma unroll
            for (int bj = 0; bj < 2; ++bj) {
                if (wr == 0 && fr < 2)   { float* h = hb + fr * 4096 + bj * HALF; *(f32x4*)h = acc[0][bj][0][0]; *(f32x4*)(h + 4) = acc[0][bj][0][1]; }
                if (wr == 1 && fr >= 14) { float* h = hb + (fr - 12) * 4096 + bj * HALF; *(f32x4*)h = acc[1][bj][3][0]; *(f32x4*)(h + 4) = acc[1][bj][3][1]; }
            }
        }
        asm volatile("s_waitcnt lgkmcnt(0)" ::: "memory");
        __builtin_amdgcn_s_barrier();
#pragma unroll
        for (int ai = 0; ai < 2; ++ai)
#pragma unroll
            for (int bj = 0; bj < 2; ++bj) {
                const int g0 = u.pn * BM + bj * HALF + wc * 32;
                const int c8 = g0 + 8 * fq;
                const int mode = (g0 >= ca_lo && g0 < ca_lo + ca_n) ? 0 : ((g0 + 32 > sb_lo && g0 < sb_lo + sb_n) ? 1 : 2);
                if (mode == 2) {
#pragma unroll
                    for (int m = 0; m < 4; ++m) {
                        const size_t row = (size_t)(row0 + ai * HALF + m * 16);
                        const f32x4 v0 = acc[ai][bj][m][0], v1 = acc[ai][bj][m][1];
                        u32x4 w; w.x = cvt_pk_bf16(v0[0], v0[1]); w.y = cvt_pk_bf16(v0[2], v0[3]); w.z = cvt_pk_bf16(v1[0], v1[1]); w.w = cvt_pk_bf16(v1[2], v1[3]);
                        *(u32x4*)(O + row * ldo + c8) = w;
                        if (side && c8 >= side_lo && c8 < side_lo + side_n) { float* sp = side + row * side_n + (c8 - side_lo); *(f32x4*)sp = v0; *(f32x4*)(sp + 4) = v1; }
                    }
                    continue;
                }
                f32x4 te[2], be[2];
                {
                    const int ia = wr == 1 ? (ai * 2 + 0) : (ai * 2 - 1), ib = wr == 0 ? (ai * 2 + 1) : (ai * 2 + 2);
                    const PG8_LAS float* pa = ex + ((ia < 0 ? 0 : ia) * 2 + 1) * 256 + bj * HALF + cl;
                    const PG8_LAS float* pb = ex + ((ib > 3 ? 3 : ib) * 2 + 0) * 256 + bj * HALF + cl;
                    te[0] = *(const PG8_LAS f32x4*)pa; te[1] = *(const PG8_LAS f32x4*)(pa + 4); be[0] = *(const PG8_LAS f32x4*)pb; be[1] = *(const PG8_LAS f32x4*)(pb + 4);
                    if (ia < 0) { te[0] = (f32x4){0.f, 0.f, 0.f, 0.f}; te[1] = te[0]; }
                    if (ib > 3) { be[0] = (f32x4){0.f, 0.f, 0.f, 0.f}; be[1] = be[0]; }
                }
                const PG8_LAS float* wp = ex + 2048 + ((const PG8_LAS int*)(ex + 6144))[u.pn] * 1024 + bj * HALF + cl;
                u32x2 ow[4][2];
                const bool f0 = fr == 0, f15 = fr == 15;
                if (mode == 0) {
#pragma unroll
                    for (int n = 0; n < 2; ++n) {
                        const f32x4 w0 = *(const PG8_LAS f32x4*)(wp + 4 * n), w1 = *(const PG8_LAS f32x4*)(wp + 256 + 4 * n), w2 = *(const PG8_LAS f32x4*)(wp + 512 + 4 * n), bb = *(const PG8_LAS f32x4*)(wp + 768 + 4 * n);
                        float o[4][4];
#pragma unroll
                        for (int e = 0; e < 4; ++e) {
                            float rp[4], rn[4];
#pragma unroll
                            for (int m = 0; m < 4; ++m) { rp[m] = dpp_prev(acc[ai][bj][m][n][e]); rn[m] = dpp_next(acc[ai][bj][m][n][e]); }
#pragma unroll
                            for (int m = 0; m < 4; ++m) {
                                const float pv = f0 ? (m == 0 ? te[n][e] : rp[m == 0 ? 0 : m - 1]) : rp[m];
                                const float nv = f15 ? (m == 3 ? be[n][e] : rn[m == 3 ? 3 : m + 1]) : rn[m];
                                const float x = bb[e] + w0[e] * pv + w1[e] * acc[ai][bj][m][n][e] + w2[e] * nv;
                                o[m][e] = x * __builtin_amdgcn_rcpf(1.f + __builtin_amdgcn_exp2f(-1.4426950408889634f * x));
                            }
                        }
#pragma unroll
                        for (int m = 0; m < 4; ++m) { ow[m][n].x = cvt_pk_bf16(o[m][0], o[m][1]); ow[m][n].y = cvt_pk_bf16(o[m][2], o[m][3]); }
                    }
                } else {
#pragma unroll
                    for (int n = 0; n < 2; ++n) {
                        const f32x4 w0 = *(const PG8_LAS f32x4*)(wp + 4 * n);
                        float o[4][4];
#pragma unroll
                        for (int e = 0; e < 4; ++e) {
                            float rp[4], rn[4];
#pragma unroll
                            for (int m = 0; m < 4; ++m) { rp[m] = dpp_prev(acc[ai][bj][m][n][e]); rn[m] = dpp_next(acc[ai][bj][m][n][e]); }
#pragma unroll
                            for (int m = 0; m < 4; ++m) {
                                const float pv = f0 ? (m == 0 ? te[n][e] : rp[m == 0 ? 0 : m - 1]) : rp[m];
                                const float nv = f15 ? (m == 3 ? be[n][e] : rn[m == 3 ? 3 : m + 1]) : rn[m];
                                const float c = acc[ai][bj][m][n][e];
                                o[m][e] = c + w0[e] * (0.5f * (pv + nv) - c);
                            }
                        }
#pragma unroll
                        for (int m = 0; m < 4; ++m) { ow[m][n].x = cvt_pk_bf16(o[m][0], o[m][1]); ow[m][n].y = cvt_pk_bf16(o[m][2], o[m][3]); }
                    }
                }
#pragma unroll
                for (int m = 0; m < 4; ++m) {
                    const size_t row = (size_t)(row0 + ai * HALF + m * 16);
                    u32x4 w; w.x = ow[m][0].x; w.y = ow[m][0].y; w.z = ow[m][1].x; w.w = ow[m][1].y;
                    *(u32x4*)(O + row * ldo + c8) = w;
                    if (side && c8 >= side_lo && c8 < side_lo + side_n) { float* sp = side + row * side_n + (c8 - side_lo); *(f32x4*)sp = acc[ai][bj][m][0]; *(f32x4*)(sp + 4) = acc[ai][bj][m][1]; }
                }
            }
    }
};
struct EpiSwiGLU {
    static constexpr bool PERM = true, AFTER_DRAIN = false;
    bf16_t* ACT; int ldo;
    __device__ __forceinline__ void operator()(const f32x4 (&acc)[2][2][4][2], const Unit& u, int wr, int wc, int fr, int fq) const {
        const int row0 = u.pm * BM + wr * 64 + fr, col0 = u.pn * HALF + wc * 32 + 8 * fq;
#pragma unroll
        for (int ai = 0; ai < 2; ++ai)
#pragma unroll
            for (int m = 0; m < 4; ++m) {
                const size_t row = (size_t)(row0 + ai * HALF + m * 16);
                float o[8];
#pragma unroll
                for (int n = 0; n < 2; ++n)
#pragma unroll
                    for (int e = 0; e < 4; ++e) o[n * 4 + e] = pg_silu(acc[ai][0][m][n][e]) * acc[ai][1][m][n][e];
                u32x4 w; w.x = cvt_pk_bf16(o[0], o[1]); w.y = cvt_pk_bf16(o[2], o[3]); w.z = cvt_pk_bf16(o[4], o[5]); w.w = cvt_pk_bf16(o[6], o[7]);
                *(u32x4*)(ACT + row * ldo + col0) = w;
            }
    }
};
struct EpiResid {
    static constexpr bool PERM = false, AFTER_DRAIN = false;
    float* X; const float* gate; const float* rowss; float rs_inv_n;
    __device__ __forceinline__ void operator()(const f32x4 (&acc)[2][2][4][2], const Unit& u, int wr, int wc, int fr, int fq) const {
        const int row0 = u.pm * BM + wr * 64 + fr, col0 = u.pn * BM + wc * 32 + 4 * fq;
        const float* g = gate + row_cls(u.pm * BM) * 6144;
        f32x4 gv[2][2];
#pragma unroll
        for (int bj = 0; bj < 2; ++bj)
#pragma unroll
            for (int n = 0; n < 2; ++n) gv[bj][n] = *(const f32x4*)(g + col0 + bj * HALF + n * 16);
#pragma unroll
        for (int ai = 0; ai < 2; ++ai)
#pragma unroll
            for (int m = 0; m < 4; ++m) {
                const size_t row = (size_t)(row0 + ai * HALF + m * 16);
                const float rs = rowss ? rsqrtf(rowss[row] * rs_inv_n + 1e-6f) : 1.f;
                float* xp = X + row * 1024 + col0;
#pragma unroll
                for (int bj = 0; bj < 2; ++bj)
#pragma unroll
                    for (int n = 0; n < 2; ++n) {
                        f32x4 x = *(const f32x4*)(xp + bj * HALF + n * 16);
                        x += gv[bj][n] * (acc[ai][bj][m][n] * rs);
                        *(f32x4*)(xp + bj * HALF + n * 16) = x;
                    }
            }
    }
};
__device__ __forceinline__ void store16_wt(void* p, u32x4 v) { asm volatile("global_store_dwordx4 %0, %1, off sc1\n\ts_nop 1" :: "v"(p), "v"(v) : "memory"); }
struct EpiResidNorm {
    static constexpr bool PERM = true, AFTER_DRAIN = true;
    bf16_t* XB; float* OUT; const float* gate; const float* rowss; float rs_inv_n;
    float* RS; unsigned* cnt; unsigned* tmo;
    const float* nw; const float* mods; int sh_idx, sc_idx; bf16_t* H;
    unsigned* done;
    __device__ __forceinline__ void operator()(const f32x4 (&)[2][2][4][2], const Unit&, int, int, int, int) const {}
    __device__ __forceinline__ void fused(f32x4 (&acc)[2][2][4][2], const Unit& u, int wr, int wc, int fr, int fq, PG8_LAS unsigned char*, int, int) const {
        const int row0 = u.pm * BM + wr * 64 + fr, col0 = u.pn * BM + wc * 32 + 8 * fq;
        const int cls = row_cls(u.pm * BM);
        {
            const float* g = gate + cls * 6144;
            f32x4 gv[2][2];
#pragma unroll
            for (int bj = 0; bj < 2; ++bj)
#pragma unroll
                for (int n = 0; n < 2; ++n) gv[bj][n] = *(const f32x4*)(g + col0 + bj * HALF + n * 4);
            u32x4 xb[2][2]; float rsb[2];
            const float* rsrc = rowss ? rowss : RS;
#define ERN_LOAD(g_, slot_) do { const size_t row_ = (size_t)(row0 + ((g_) >> 2) * HALF + ((g_) & 3) * 16); const bf16_t* xp_ = XB + row_ * 1024 + col0; \
                _Pragma("unroll") for (int bj_ = 0; bj_ < 2; ++bj_) xb[slot_][bj_] = *(const u32x4*)(xp_ + bj_ * HALF); \
                rsb[slot_] = rsrc[row_]; } while (0)
            ERN_LOAD(0, 0);
#pragma unroll
            for (int g = 0; g < 8; ++g) {
                const int ai = g >> 2, m = g & 3, sl = g & 1;
                if (g < 7) ERN_LOAD(g + 1, sl ^ 1);
                const size_t row = (size_t)(row0 + ai * HALF + m * 16);
                const float rs = rowss ? rsqrtf(rsb[sl] * rs_inv_n + 1e-6f) : 1.f;
                float ss = 0.f;
#pragma unroll
                for (int bj = 0; bj < 2; ++bj)
#pragma unroll
                    for (int n = 0; n < 2; ++n) {
                        const u32x2 xr = n == 0 ? (u32x2){xb[sl][bj].x, xb[sl][bj].y} : (u32x2){xb[sl][bj].z, xb[sl][bj].w};
                        f32x4 x = {__builtin_bit_cast(float, xr.x << 16), __builtin_bit_cast(float, xr.x & 0xffff0000u), __builtin_bit_cast(float, xr.y << 16), __builtin_bit_cast(float, xr.y & 0xffff0000u)};
                        x += gv[bj][n] * (acc[ai][bj][m][n] * rs);
                        acc[ai][bj][m][n] = x;
                        ss += x[0] * x[0] + x[1] * x[1] + x[2] * x[2] + x[3] * x[3];
                    }
                ss += __shfl_xor(ss, 16); ss += __shfl_xor(ss, 32);
                if (fq == 0) atomicAdd(RS + row, ss);
            }
#undef ERN_LOAD
        }
        asm volatile("s_waitcnt vmcnt(0)" ::: "memory");
        __syncthreads();
        if (threadIdx.x == 0) (void)__hip_atomic_fetch_add(cnt + u.pm, 1u, __ATOMIC_RELAXED, __HIP_MEMORY_SCOPE_AGENT);
        if (mods) {
#pragma unroll
            for (int ai = 0; ai < 2; ++ai)
#pragma unroll
                for (int m = 0; m < 4; ++m) {
                    bf16_t* xp = XB + (size_t)(row0 + ai * HALF + m * 16) * 1024 + col0;
#pragma unroll
                    for (int bj = 0; bj < 2; ++bj) { const f32x4 x0 = acc[ai][bj][m][0], x1 = acc[ai][bj][m][1];
                        u32x4 w; w.x = cvt_pk_bf16(x0[0], x0[1]); w.y = cvt_pk_bf16(x0[2], x0[3]); w.z = cvt_pk_bf16(x1[0], x1[1]); w.w = cvt_pk_bf16(x1[2], x1[3]); *(u32x4*)(xp + bj * HALF) = w; }
                }
        }
        f32x4 wv[2][2], sv[2][2];
#pragma unroll
        for (int bj = 0; bj < 2; ++bj)
#pragma unroll
            for (int n = 0; n < 2; ++n) {
                const int c = col0 + bj * HALF + n * 4;
                const float* mb = mods ? mods : nw;
                const f32x4 s1 = *(const f32x4*)(mb + (mods ? cls * 6144 + sc_idx * 1024 : 0) + c), s0 = *(const f32x4*)(mb + (mods ? cls * 6144 + sh_idx * 1024 : 0) + c);
                wv[bj][n] = *(const f32x4*)(nw + c); sv[bj][n] = (f32x4){0.f, 0.f, 0.f, 0.f};
                if (mods) { wv[bj][n] *= (s1 + 1.f); sv[bj][n] = s0; }
            }
        if (threadIdx.x == 0) {
            unsigned* c = cnt + u.pm;
            unsigned sp = 0;
            while (__hip_atomic_load(c, __ATOMIC_RELAXED, __HIP_MEMORY_SCOPE_AGENT) < 4u) {
                __builtin_amdgcn_s_sleep(1);
                if ((++sp & 255u) == 0u) { if (__hip_atomic_load(tmo, __ATOMIC_RELAXED, __HIP_MEMORY_SCOPE_AGENT)) break; if (sp > (1u << 25)) { atomicAdd(tmo, 1u); break; } }
            }
        }
        __syncthreads();
        float rstd[2][4];
#pragma unroll
        for (int ai = 0; ai < 2; ++ai)
#pragma unroll
            for (int m = 0; m < 4; ++m)
                rstd[ai][m] = rsqrtf(__hip_atomic_load(RS + (size_t)(row0 + ai * HALF + m * 16), __ATOMIC_RELAXED, __HIP_MEMORY_SCOPE_AGENT) * (1.f / 1024.f) + 1e-6f);
#pragma unroll
        for (int bj = 0; bj < 2; ++bj) {
            const int c = col0 + bj * HALF;
#pragma unroll
            for (int ai = 0; ai < 2; ++ai)
#pragma unroll
                for (int m = 0; m < 4; ++m) {
                    const f32x4 o0 = acc[ai][bj][m][0] * rstd[ai][m] * wv[bj][0] + sv[bj][0], o1 = acc[ai][bj][m][1] * rstd[ai][m] * wv[bj][1] + sv[bj][1];
                    const size_t off = (size_t)(row0 + ai * HALF + m * 16) * 1024 + c;
                    if (mods) { u32x4 w; w.x = cvt_pk_bf16(o0[0], o0[1]); w.y = cvt_pk_bf16(o0[2], o0[3]); w.z = cvt_pk_bf16(o1[0], o1[1]); w.w = cvt_pk_bf16(o1[2], o1[3]); if (done) store16_wt(H + off, w); else *(u32x4*)(H + off) = w; }
                    else { *(f32x4*)(OUT + off) = o0; *(f32x4*)(OUT + off + 4) = o1; }
                }
        }
        if (done) {
            asm volatile("s_waitcnt vmcnt(0)" ::: "memory");
            __syncthreads();
            if (threadIdx.x == 0) (void)__hip_atomic_fetch_add(done + u.pm, 1u, __ATOMIC_RELAXED, __HIP_MEMORY_SCOPE_AGENT);
        }
        if (!mods && threadIdx.x == 0 && __hip_atomic_load(tmo, __ATOMIC_RELAXED, __HIP_MEMORY_SCOPE_AGENT) != 0u) OUT[(size_t)(u.pm * BM) * 1024 + u.pn * BM] = __builtin_nanf("");
    }
};
struct EpiGateZ {
    static constexpr bool PERM = true, AFTER_DRAIN = false;
    const bf16_t* YS; bf16_t* Y2; int ld; float* rowss;
    unsigned* topgen; unsigned* tmo;
    const bf16_t* YS2;
    __device__ __forceinline__ void operator()(const f32x4 (&acc)[2][2][4][2], const Unit& u, int wr, int wc, int fr, int fq) const {
        const int row0 = u.pm * BM + wr * 64 + fr, col0 = u.pn * BM + wc * 32 + 8 * fq;
        if (topgen && u.pn < 4) {
            if (threadIdx.x == 0) {
                unsigned sp = 0;
                while (__hip_atomic_load(topgen, __ATOMIC_RELAXED, __HIP_MEMORY_SCOPE_AGENT) == 0u) {
                    __builtin_amdgcn_s_sleep(1);
                    if ((++sp & 255u) == 0u) { if (__hip_atomic_load(tmo, __ATOMIC_RELAXED, __HIP_MEMORY_SCOPE_AGENT)) break; if (sp > (1u << 25)) { atomicAdd(tmo, 1u); break; } }
                }
                __builtin_amdgcn_fence(__ATOMIC_ACQUIRE, "agent");
            }
            __builtin_amdgcn_s_barrier();
        }
        u32x4 yb[2][2], yc[2][2];
        const bool latt = u.pm >= 32; const float latw = latt ? 1.f : 0.f;
#define EGZ_LOAD(g_, slot_) do { const size_t row_ = (size_t)(row0 + ((g_) >> 2) * HALF + ((g_) & 3) * 16); \
            _Pragma("unroll") for (int bj_ = 0; bj_ < 2; ++bj_) { const int cgl_ = col0 + bj_ * HALF; \
                const size_t sl_ = (size_t)(((cgl_ >> 5) & 1) * 32 + (cgl_ >> 6)); const bf16_t* p1_ = YS + (sl_ * 16384 + row_) * 32 + (cgl_ & 31); \
                yb[slot_][bj_] = *(const u32x4*)p1_; yc[slot_][bj_] = *(const u32x4*)(latt ? YS2 + (sl_ * 8192 + (row_ - 8192)) * 32 + (cgl_ & 31) : p1_); } } while (0)
        EGZ_LOAD(0, 0);
#pragma unroll
        for (int g = 0; g < 8; ++g) {
            const int ai = g >> 2, m = g & 3, sl = g & 1;
            if (g < 7) EGZ_LOAD(g + 1, sl ^ 1);
            const size_t row = (size_t)(row0 + ai * HALF + m * 16);
            float ss = 0.f;
#pragma unroll
            for (int bj = 0; bj < 2; ++bj) {
                const size_t po = row * ld + col0 + bj * HALF;
                const u32x4 y = yb[sl][bj], y2 = yc[sl][bj];
                const unsigned yy[4] = {y.x, y.y, y.z, y.w}, yz[4] = {y2.x, y2.y, y2.z, y2.w};
                float o[8];
#pragma unroll
                for (int e = 0; e < 8; ++e) {
                    const float ys = __uint_as_float((e & 1) ? (yy[e >> 1] & 0xffff0000u) : (yy[e >> 1] << 16)) + latw * __uint_as_float((e & 1) ? (yz[e >> 1] & 0xffff0000u) : (yz[e >> 1] << 16));
                    const float z = acc[ai][bj][m][e >> 2][e & 3];
                    o[e] = ys * pg_silu(z);
                }
                u32x4 w; w.x = cvt_pk_bf16(o[0], o[1]); w.y = cvt_pk_bf16(o[2], o[3]); w.z = cvt_pk_bf16(o[4], o[5]); w.w = cvt_pk_bf16(o[6], o[7]);
                *(u32x4*)(Y2 + po) = w;
#pragma unroll
                for (int e = 0; e < 4; ++e) {
                    const unsigned ww = e == 0 ? w.x : e == 1 ? w.y : e == 2 ? w.z : w.w;
                    const float lo = __uint_as_float(ww << 16), hi = __uint_as_float(ww & 0xffff0000u);
                    ss += lo * lo + hi * hi;
                }
            }
            ss += __shfl_xor(ss, 16); ss += __shfl_xor(ss, 32);
            if (fq == 0) atomicAdd(rowss + row, ss);
        }
#undef EGZ_LOAD
    }
};
template <class Epi, class Sched, bool ALIGN_EPI = false, bool SP2 = false>
__device__ __forceinline__ void gemm_phase(PG8_LAS unsigned char* lds, const Gemm g, const Sched& S, const Epi& E) {
    int tid_l = threadIdx.x; asm volatile("" : "+v"(tid_l));
    const int tid = tid_l, wid = __builtin_amdgcn_readfirstlane(tid >> 6), lane = tid & 63, wr = wid >> 2, wc = wid & 3, fr = lane & 15, fq = lane >> 4;
    const int K = g.K, nt = K / BK;
    unsigned voffA[2], voffB[2];
#pragma unroll
    for (int i = 0; i < 2; ++i) { int R, C; stage_rc(tid * 16 + i * 8192, R, C); const int Rb = Epi::PERM ? ((R & ~31) + perm32(R & 31)) : R;
        voffA[i] = (unsigned)(R * K + C) * 2u; voffB[i] = (unsigned)(Rb * K + C) * 2u; }
    const size_t kstep = (size_t)(BK * 2);
    const size_t hstep = (size_t)HALF * K * 2;
    const size_t tstep = 2 * hstep;
    const unsigned ldsw = (unsigned)wid * 1024u;
    const int aoff = lds_byte(wr * 64 + fr, fq * 8), boff = lds_byte(wc * 32 + fr, fq * 8);
#define PG8_SA(b, h) (((b) * 2 + (h)) * HTB)
#define PG8_SB(b, h) ((4 + (b) * 2 + (h)) * HTB)
#define PG8_STAGE(bufoff, gbase, voff) do { _Pragma("unroll") for (int _i = 0; _i < 2; ++_i) \
        __builtin_amdgcn_global_load_lds((const unsigned*)((const char*)(gbase) + (voff)[_i]), (PG8_LAS unsigned*)(lds + (bufoff) + ldsw + _i * 8192), 16, 0, 0); } while (0)
#define PG8_LDA(dst, b, h) do { _Pragma("unroll") for (int m = 0; m < 4; ++m) _Pragma("unroll") for (int k = 0; k < 2; ++k) dst[m][k] = *(const PG8_LAS bf16x8*)(lds + PG8_SA(b, h) + aoff + m * 2048 + k * 1024); } while (0)
#define PG8_LDB(dst, b, h) do { _Pragma("unroll") for (int n = 0; n < 2; ++n) _Pragma("unroll") for (int k = 0; k < 2; ++k) dst[n][k] = *(const PG8_LAS bf16x8*)(lds + PG8_SB(b, h) + boff + n * 2048 + k * 1024); } while (0)
#define PG8_MMA(ai, bj, At, Bt) do { __builtin_amdgcn_s_setprio(1); _Pragma("unroll") for (int m = 0; m < 4; ++m) _Pragma("unroll") for (int n = 0; n < 2; ++n) _Pragma("unroll") for (int k = 0; k < 2; ++k) \
        acc[ai][bj][m][n] = __builtin_amdgcn_mfma_f32_16x16x32_bf16(Bt[n][k], At[m][k], acc[ai][bj][m][n], 0, 0, 0); __builtin_amdgcn_s_setprio(0); } while (0)
#define PG8_WAIT_V(n) asm volatile("s_waitcnt vmcnt(" #n ")" ::: "memory")
#define PG8_WAIT_L(n) asm volatile("s_waitcnt lgkmcnt(" #n ")" ::: "memory")
#define PG8_BAR __builtin_amdgcn_s_barrier()
#define PG8_SCHED __builtin_amdgcn_sched_barrier(0)
    Unit cur, nxt; int ui = 0;
    if (!S.next(0, cur)) return;
    f32x4 acc[2][2][4][2];
#pragma unroll
    for (int a = 0; a < 2; ++a)
#pragma unroll
        for (int b = 0; b < 2; ++b)
#pragma unroll
            for (int m = 0; m < 4; ++m)
#pragma unroll
                for (int n = 0; n < 2; ++n) acc[a][b][m][n] = (f32x4){0.f, 0.f, 0.f, 0.f};
    bf16x8 At[4][2], B0[2][2], B1[2][2];
    const char* cA = (const char*)g.A + (size_t)cur.pm * tstep; const char* cB = (const char*)g.Bt + (size_t)cur.pn * tstep;
    S.a_ready(cur);
    if constexpr (SP2) {
        PG8_STAGE(PG8_SB(0, 0), cB, voffB); PG8_STAGE(PG8_SB(0, 1), cB + hstep, voffB); PG8_STAGE(PG8_SA(0, 0), cA, voffA); PG8_STAGE(PG8_SA(0, 1), cA + hstep, voffA);
        if (wr == 1) PG8_BAR;
        PG8_WAIT_V(2); PG8_BAR;
        PG8_STAGE(PG8_SB(1, 0), cB + kstep, voffB); PG8_STAGE(PG8_SA(1, 0), cA + kstep, voffA); PG8_STAGE(PG8_SB(1, 1), cB + hstep + kstep, voffB);
        PG8_WAIT_V(6); PG8_BAR;
    } else {
        PG8_STAGE(PG8_SB(0, 0), cB, voffB); PG8_STAGE(PG8_SA(0, 0), cA, voffA); PG8_STAGE(PG8_SB(0, 1), cB + hstep, voffB); PG8_STAGE(PG8_SA(0, 1), cA + hstep, voffA);
        if (wr == 1) PG8_BAR;
        PG8_WAIT_V(4); PG8_BAR;
        PG8_STAGE(PG8_SB(1, 0), cB + kstep, voffB); PG8_STAGE(PG8_SA(1, 0), cA + kstep, voffA); PG8_STAGE(PG8_SB(1, 1), cB + hstep + kstep, voffB);
        PG8_WAIT_V(6); PG8_BAR;
    }
    for (;;) {
        const bool has_next = S.next(ui + 1, nxt);
        const char* nA = has_next ? (const char*)g.A + (size_t)nxt.pm * tstep : cA; const char* nB = has_next ? (const char*)g.Bt + (size_t)nxt.pn * tstep : cB;
        for (int t = 0; t < nt; t += 2) {
            const bool last = (t == nt - 2);
            const char* a1 = cA + (size_t)(t + 1) * kstep;
            const char* a2 = last ? nA : cA + (size_t)(t + 2) * kstep; const char* b2 = last ? nB : cB + (size_t)(t + 2) * kstep;
            const char* a3 = a2 + kstep; const char* b3 = b2 + kstep;
            if (last && has_next) S.a_ready(nxt);
            if constexpr (SP2) {
            PG8_LDB(B0, 0, 0); PG8_LDB(B1, 0, 1); PG8_SCHED; PG8_LDA(At, 0, 0); PG8_STAGE(PG8_SA(1, 1), a1 + hstep, voffA);
            PG8_WAIT_V(8); PG8_WAIT_L(0); PG8_BAR; PG8_MMA(0, 0, At, B0); PG8_MMA(0, 1, At, B1); PG8_BAR; PG8_SCHED;
            PG8_LDA(At, 0, 1); PG8_STAGE(PG8_SB(0, 0), b2, voffB); PG8_STAGE(PG8_SB(0, 1), b2 + hstep, voffB); PG8_STAGE(PG8_SA(0, 0), a2, voffA);
            PG8_WAIT_V(8); PG8_WAIT_L(0); PG8_BAR; PG8_MMA(1, 0, At, B0); PG8_MMA(1, 1, At, B1); PG8_BAR; PG8_SCHED;
            PG8_LDB(B0, 1, 0); PG8_LDB(B1, 1, 1); PG8_SCHED; PG8_LDA(At, 1, 0); PG8_STAGE(PG8_SA(0, 1), a2 + hstep, voffA);
            PG8_WAIT_V(8); PG8_WAIT_L(0); PG8_BAR; PG8_MMA(0, 0, At, B0); PG8_MMA(0, 1, At, B1); PG8_BAR; PG8_SCHED;
            PG8_LDA(At, 1, 1); PG8_STAGE(PG8_SB(1, 0), b3, voffB); PG8_STAGE(PG8_SB(1, 1), b3 + hstep, voffB); PG8_STAGE(PG8_SA(1, 0), a3, voffA);
            PG8_WAIT_V(8); PG8_WAIT_L(0); PG8_BAR; PG8_MMA(1, 0, At, B0); PG8_MMA(1, 1, At, B1); PG8_BAR; PG8_SCHED;
            } else {
            PG8_LDB(B0, 0, 0); PG8_SCHED; PG8_LDA(At, 0, 0); PG8_STAGE(PG8_SA(1, 1), a1 + hstep, voffA);
            PG8_WAIT_L(8); PG8_BAR; PG8_WAIT_L(0); PG8_MMA(0, 0, At, B0); PG8_BAR; PG8_SCHED;
            PG8_LDB(B1, 0, 1); PG8_STAGE(PG8_SB(0, 0), b2, voffB);
            PG8_BAR; PG8_WAIT_L(0); PG8_MMA(0, 1, At, B1); PG8_BAR;
            PG8_LDA(At, 0, 1); PG8_STAGE(PG8_SA(0, 0), a2, voffA);
            PG8_BAR; PG8_WAIT_L(0); PG8_MMA(1, 0, At, B0); PG8_BAR; PG8_SCHED;
            PG8_STAGE(PG8_SB(0, 1), b2 + hstep, voffB);
            PG8_WAIT_V(6); PG8_BAR; PG8_MMA(1, 1, At, B1); PG8_BAR;
            PG8_LDB(B0, 1, 0); PG8_SCHED; PG8_LDA(At, 1, 0); PG8_STAGE(PG8_SA(0, 1), a2 + hstep, voffA);
            PG8_WAIT_L(8); PG8_BAR; PG8_WAIT_L(0); PG8_MMA(0, 0, At, B0); PG8_BAR; PG8_SCHED;
            PG8_LDB(B1, 1, 1); PG8_STAGE(PG8_SB(1, 0), b3, voffB);
            PG8_BAR; PG8_WAIT_L(0); PG8_MMA(0, 1, At, B1); PG8_BAR;
            PG8_LDA(At, 1, 1); PG8_STAGE(PG8_SA(1, 0), a3, voffA);
            PG8_BAR; PG8_WAIT_L(0); PG8_MMA(1, 0, At, B0); PG8_BAR; PG8_SCHED;
            PG8_STAGE(PG8_SB(1, 1), b3 + hstep, voffB);
            PG8_WAIT_V(6); PG8_BAR; PG8_MMA(1, 1, At, B1); PG8_BAR;
            }
        }
        if constexpr (ALIGN_EPI) { if (wr == 0) PG8_BAR; }
        if constexpr (!Epi::AFTER_DRAIN) { E(acc, cur, wr, wc, fr, fq); S.done(cur); }
        if (!has_next) break;
#pragma unroll
        for (int a = 0; a < 2; ++a)
#pragma unroll
            for (int b = 0; b < 2; ++b)
#pragma unroll
                for (int m = 0; m < 4; ++m)
#pragma unroll
                    for (int n = 0; n < 2; ++n) acc[a][b][m][n] = (f32x4){0.f, 0.f, 0.f, 0.f};
        cur = nxt; cA = nA; cB = nB; ++ui;
        if constexpr (ALIGN_EPI) { if (wr == 1) PG8_BAR; }
    }
    PG8_WAIT_V(0);
    if constexpr (!ALIGN_EPI) { if (wr == 0) PG8_BAR; }
    PG8_BAR;
    if constexpr (Epi::AFTER_DRAIN) { E.fused(acc, cur, wr, wc, fr, fq, lds, wid, lane); S.done(cur); }
#undef PG8_SA
#undef PG8_SB
#undef PG8_STAGE
#undef PG8_LDA
#undef PG8_LDB
#undef PG8_MMA
#undef PG8_WAIT_V
#undef PG8_WAIT_L
#undef PG8_BAR
#undef PG8_SCHED
}
}


struct ConvJob { const float* W; const float* kscale; bf16_t* WT; int ldw, K, Ndst, mode, c0, nvalid, item0, nitems; };
constexpr int MAX_CONV = 6;
struct ConvArgs { ConvJob j[MAX_CONV]; int njobs, total, pad0, pad1; };

DEV void conv_item(const ConvJob& J, int item, float* scr, int lane) {
    const int nblk = J.Ndst / 32, kb = item / nblk, nb = item % nblk, k0 = 64 * kb, n0 = 32 * nb;
    int sc0, nv;
    if (J.mode == 0) { sc0 = J.c0 + n0; nv = J.nvalid - n0; } else { sc0 = ((n0 >> 7) & 1) * 2816 + (n0 >> 8) * 128 + (n0 & 127); nv = 32; }
    const int cc = lane & 31;
    const bool ok = cc < nv;
    const float* src = J.W + (size_t)(k0 + (lane >> 5)) * J.ldw + sc0 + (ok ? cc : 0);
    float v[32];
#pragma unroll
    for (int i = 0; i < 32; ++i) v[i] = src[(size_t)(2 * i) * J.ldw];
    if (J.kscale) {
#pragma unroll
        for (int i = 0; i < 32; ++i) v[i] *= J.kscale[k0 + 2 * i + (lane >> 5)];
    }
#pragma unroll
    for (int i = 0; i < 32; ++i) scr[(2 * i + (lane >> 5)) * 33 + cc] = ok ? v[i] : 0.f;
    asm volatile("s_waitcnt lgkmcnt(0)" ::: "memory");
    const int c = lane & 7;
#pragma unroll
    for (int j = 0; j < 4; ++j) {
        const int n = (lane >> 3) + 8 * j;
        const float* s = scr + (8 * c) * 33 + n;
        uint4 o;
        o.x = pg8::cvt_pk_bf16(s[0 * 33], s[1 * 33]); o.y = pg8::cvt_pk_bf16(s[2 * 33], s[3 * 33]);
        o.z = pg8::cvt_pk_bf16(s[4 * 33], s[5 * 33]); o.w = pg8::cvt_pk_bf16(s[6 * 33], s[7 * 33]);
        *(uint4*)(J.WT + (size_t)(n0 + n) * J.K + k0 + 8 * c) = o;
    }
    asm volatile("s_waitcnt lgkmcnt(0)" ::: "memory");
}
DEV void conv_all(const ConvArgs& a, float* scr_wave, int gw, int ngw, int lane) {
    for (int it = gw; it < a.total; it += ngw) {
#pragma unroll
        for (int ji = 0; ji < MAX_CONV; ++ji)
            if (ji < a.njobs && it >= a.j[ji].item0 && it < a.j[ji].item0 + a.j[ji].nitems) conv_item(a.j[ji], it - a.j[ji].item0, scr_wave, lane);
    }
}

DEV uint2 pack4_bf16(float a, float b, float c, float d) { uint2 r; r.x = pg8::cvt_pk_bf16(a, b); r.y = pg8::cvt_pk_bf16(c, d); return r; }

DEV void unpack8(const uint4 raw, float (&f)[8]) {
    f[0] = __uint_as_float(raw.x << 16); f[1] = __uint_as_float(raw.x & 0xffff0000u);
    f[2] = __uint_as_float(raw.y << 16); f[3] = __uint_as_float(raw.y & 0xffff0000u);
    f[4] = __uint_as_float(raw.z << 16); f[5] = __uint_as_float(raw.z & 0xffff0000u);
    f[6] = __uint_as_float(raw.w << 16); f[7] = __uint_as_float(raw.w & 0xffff0000u);
}
DEV uint4 pack8(const float (&f)[8]) {
    uint4 w; w.x = pg8::cvt_pk_bf16(f[0], f[1]); w.y = pg8::cvt_pk_bf16(f[2], f[3]); w.z = pg8::cvt_pk_bf16(f[4], f[5]); w.w = pg8::cvt_pk_bf16(f[6], f[7]); return w;
}


DEV bf16_t* had_slab(bf16_t* A, bf16_t* B, int slab) { return slab < 28 ? A + (size_t)slab * M_ROWS * 32 : B + (size_t)(slab - 28) * M_ROWS * 32; }
DEV const bf16_t* had_slab(const bf16_t* A, const bf16_t* B, int slab) { return slab < 28 ? A + (size_t)slab * M_ROWS * 32 : B + (size_t)(slab - 28) * M_ROWS * 32; }
DEV void phase_embed(const float* xp, const float* xs, float* X, int gw, int ngw, int lane) {
    for (int row = gw; row < M_ROWS; row += ngw) {
        const float* src = row < 8192 ? xp + (size_t)row * 1024 : xs + (size_t)(row - 8192) * 1024;
        const int t = (row - 8192) & 4095;
#pragma unroll
        for (int j = 0; j < 4; ++j) {
            const int c = (lane + 64 * j) * 4;
            float4 v = *(const float4*)(src + c);
            if (row >= 8192) {
                float e[4];
#pragma unroll
                for (int q = 0; q < 4; ++q) {
                    const int cc = c + q, seg = cc >> 8, i = cc & 255;
                    const float freq = expf(-9.210340371976184f * (float)i / 256.f);
                    const float pos = (seg < 2) ? (float)(t >> 6) : (float)(t & 63);
                    const float arg = pos * freq;
                    e[q] = (seg & 1) ? cosf(arg) : sinf(arg);
                }
                v.x += e[0]; v.y += e[1]; v.z += e[2]; v.w += e[3];
            }
            *(float4*)(X + (size_t)row * 1024 + c) = v;
        }
    }
}

DEV void phase_embed_norm(const float* xp, const float* xs, const float* TPOS, bf16_t* XB, const float* nw, const float* mods_l, int sh_idx, int sc_idx, bf16_t* H, int gw, int ngw, int lane) {
    float4 xv[2][4], ev[2][4];
#define EN_LOAD(row_, slot_) do { const int r_ = (row_) < M_ROWS ? (row_) : M_ROWS - 1; const float* src_ = r_ < 8192 ? xp + (size_t)r_ * 1024 : xs + (size_t)(r_ - 8192) * 1024; \
        const int t_ = (r_ - 8192) & 4095; \
        _Pragma("unroll") for (int j_ = 0; j_ < 4; ++j_) { const int c_ = (lane + 64 * j_) * 4, seg_ = c_ >> 8; \
            xv[slot_][j_] = *(const float4*)(src_ + c_); \
            ev[slot_][j_] = *(const float4*)(TPOS + ((seg_ < 2) ? (t_ >> 6) : (t_ & 63)) * 512 + (seg_ & 1) * 256 + (c_ & 255)); } } while (0)
    EN_LOAD(gw, 0);
    int sl = 0;
    for (int row = gw; row < M_ROWS; row += ngw, sl ^= 1) {
        if (sl == 0) EN_LOAD(row + ngw, 1); else EN_LOAD(row + ngw, 0);
        const float lat = row >= 8192 ? 1.f : 0.f;
        float4 v[4]; float ss = 0.f;
#pragma unroll
        for (int j = 0; j < 4; ++j) {
            const int c = (lane + 64 * j) * 4;
            float4 x = sl == 0 ? xv[0][j] : xv[1][j]; const float4 e = sl == 0 ? ev[0][j] : ev[1][j];
            x.x += lat * e.x; x.y += lat * e.y; x.z += lat * e.z; x.w += lat * e.w;
            *(uint2*)(XB + (size_t)row * 1024 + c) = pack4_bf16(x.x, x.y, x.z, x.w);
            v[j] = x; ss += x.x * x.x + x.y * x.y + x.z * x.z + x.w * x.w;
        }
        ss = wave_sum(ss);
        const float rstd = rsqrtf(ss * (1.f / 1024.f) + 1e-6f);
        const int cls = row_cls(row);
        const float* sh = mods_l + cls * 6144 + sh_idx * 1024;
        const float* sc = mods_l + cls * 6144 + sc_idx * 1024;
#pragma unroll
        for (int j = 0; j < 4; ++j) {
            const int c = (lane + 64 * j) * 4;
            const float4 w = *(const float4*)(nw + c), s1 = *(const float4*)(sc + c), s0 = *(const float4*)(sh + c);
            const float o0 = v[j].x * rstd * w.x * (1.f + s1.x) + s0.x, o1 = v[j].y * rstd * w.y * (1.f + s1.y) + s0.y;
            const float o2 = v[j].z * rstd * w.z * (1.f + s1.z) + s0.z, o3 = v[j].w * rstd * w.w * (1.f + s1.w) + s0.w;
            *(uint2*)(H + (size_t)row * 1024 + c) = pack4_bf16(o0, o1, o2, o3);
        }
    }
#undef EN_LOAD
}
DEV void phase_norm(const float* X, const float* nw, const float* mods_l, int sh_idx, int sc_idx, bf16_t* H, int gw, int ngw, int lane) {
    for (int row = gw; row < M_ROWS; row += ngw) {
        const float4* xr = (const float4*)(X + (size_t)row * 1024) + lane;
        float4 v[4]; float ss = 0.f;
#pragma unroll
        for (int j = 0; j < 4; ++j) { v[j] = xr[64 * j]; ss += v[j].x * v[j].x + v[j].y * v[j].y + v[j].z * v[j].z + v[j].w * v[j].w; }
        ss = wave_sum(ss);
        const float rstd = rsqrtf(ss * (1.f / 1024.f) + 1e-6f);
        const int cls = row_cls(row);
        const float* sh = mods_l + cls * 6144 + sh_idx * 1024;
        const float* sc = mods_l + cls * 6144 + sc_idx * 1024;
#pragma unroll
        for (int j = 0; j < 4; ++j) {
            const int c = (lane + 64 * j) * 4;
            const float4 w = *(const float4*)(nw + c), s1 = *(const float4*)(sc + c), s0 = *(const float4*)(sh + c);
            const float o0 = v[j].x * rstd * w.x * (1.f + s1.x) + s0.x, o1 = v[j].y * rstd * w.y * (1.f + s1.y) + s0.y;
            const float o2 = v[j].z * rstd * w.z * (1.f + s1.z) + s0.z, o3 = v[j].w * rstd * w.w * (1.f + s1.w) + s0.w;
            *(uint2*)(H + (size_t)row * 1024 + c) = pack4_bf16(o0, o1, o2, o3);
        }
    }
}
DEV void phase_final_norm(float* X, const float* nw, int gw, int ngw, int lane) {
    for (int row = gw; row < M_ROWS; row += ngw) {
        float4* xr = (float4*)(X + (size_t)row * 1024) + lane;
        float4 v[4]; float ss = 0.f;
#pragma unroll
        for (int j = 0; j < 4; ++j) { v[j] = xr[64 * j]; ss += v[j].x * v[j].x + v[j].y * v[j].y + v[j].z * v[j].z + v[j].w * v[j].w; }
        ss = wave_sum(ss);
        const float rstd = rsqrtf(ss * (1.f / 1024.f) + 1e-6f);
#pragma unroll
        for (int j = 0; j < 4; ++j) {
            const float4 w = *(const float4*)(nw + (lane + 64 * j) * 4);
            xr[64 * j] = make_float4(v[j].x * rstd * w.x, v[j].y * rstd * w.y, v[j].z * rstd * w.z, v[j].w * rstd * w.w);
        }
    }
}

DEV void phase_mods(const float* c, const float* c_ctx, const float* mod_w, const float* mod_b, float* MODS, unsigned char* lds, int tid, int blk, int nblk) {
    float* s = (float*)lds;
    float* red = (float*)(lds + 12288);
    for (int i = tid; i < 3072; i += 512) { const int cls = i >> 10, k = i & 1023; const float v = cls == 0 ? c_ctx[k] : c[(cls - 1) * 1024 + k]; s[i] = siluf_(v); }
    __syncthreads();
    const int col = tid & 15, ks = tid >> 4;
    for (int tile = blk; tile < 768; tile += nblk) {
        const int l = tile / 384, j0 = (tile % 384) * 16;
        const float* W = mod_w + (size_t)l * 1024 * 6144 + j0 + col;
        float a0 = 0.f, a1 = 0.f, a2 = 0.f;
#pragma unroll 8
        for (int k = ks * 32; k < ks * 32 + 32; ++k) { const float w = W[(size_t)k * 6144]; a0 += s[k] * w; a1 += s[1024 + k] * w; a2 += s[2048 + k] * w; }
        red[(ks * 3 + 0) * 16 + col] = a0; red[(ks * 3 + 1) * 16 + col] = a1; red[(ks * 3 + 2) * 16 + col] = a2;
        __syncthreads();
        if (tid < 48) {
            const int cls = tid >> 4;
            float acc = mod_b[l * 6144 + j0 + col];
#pragma unroll
            for (int q = 0; q < 32; ++q) acc += red[(q * 3 + cls) * 16 + col];
            MODS[(l * 3 + cls) * 6144 + j0 + col] = acc;
        }
        __syncthreads();
    }
}

DEV void phase_even_combine(const bf16_t* P, const bf16_t* HAD, const bf16_t* HAD2, const bf16_t* YBD, const float* RK, const float* a_norm_w, const float* mu, const float* g_up,
                            const float* ln_w, const float* ln_b, bf16_t* Y, float* gl, int gw, int ngw, int lane) {
    for (int row = gw; row < M_ROWS; row += ngw) {
        int t, T; row_tT(row, t, T);
        const size_t r = (size_t)row;
#pragma unroll
        for (int q = 0; q < 2; ++q) {
            const int idx = lane + 64 * q, pbcol = 1728 + idx, col = 2064 + pbcol;
            gl[idx] = sigmoidf_(bf2f(P[r * PLD + col]));
        }
        asm volatile("s_waitcnt lgkmcnt(0)" ::: "memory");
        const int c0 = lane * 8;
        {
            float x[8]; float s = 0.f;
            {
                const int hh = c0 >> 7, cc = c0 & 127, vq = cc >> 5, c5 = cc & 31;
                float f0[8], f1[8];
                unpack8(*(const uint4*)(had_slab(HAD, HAD2, (0 * 4 + vq) * 4 + hh) + r * 32 + c5), f0);
                unpack8(*(const uint4*)(had_slab(HAD, HAD2, (1 * 4 + vq) * 4 + hh) + r * 32 + c5), f1);
#pragma unroll
                for (int e = 0; e < 8; ++e) { x[e] = f0[e] + f1[e]; s += x[e]; }
            }
#pragma unroll
            for (int o = 1; o < 16; o <<= 1) s += __shfl_xor(s, o);
            const float mean = s * (1.f / 128.f);
            float q = 0.f;
#pragma unroll
            for (int e = 0; e < 8; ++e) { x[e] -= mean; q += x[e] * x[e]; }
#pragma unroll
            for (int o = 1; o < 16; o <<= 1) q += __shfl_xor(q, o);
            const float rs = rsqrtf(q * (1.f / 128.f) + 1e-6f);
            float y[8];
#pragma unroll
            for (int e = 0; e < 8; ++e) y[e] = x[e] * rs * a_norm_w[c0 + e] * sigmoidf_(bf2f(P[r * PLD + 1536 + c0 + e]));
            uint4 w; w.x = pg8::cvt_pk_bf16(y[0], y[1]); w.y = pg8::cvt_pk_bf16(y[2], y[3]); w.z = pg8::cvt_pk_bf16(y[4], y[5]); w.w = pg8::cvt_pk_bf16(y[6], y[7]);
            *(uint4*)(Y + r * 1024 + c0) = w;
        }
        {
            float x[8]; float s = 0.f;
            const int hd = c0 >> 6, c6 = c0 & 63;
            {
                float f0[8], f1[8];
                unpack8(*(const uint4*)(YBD + ((size_t)(0 * 8 + hd) * M_ROWS + r) * 64 + c6), f0);
                unpack8(*(const uint4*)(YBD + ((size_t)(1 * 8 + hd) * M_ROWS + r) * 64 + c6), f1);
#pragma unroll
                for (int e = 0; e < 8; ++e) { x[e] = f0[e] + f1[e]; s += x[e]; }
            }
#pragma unroll
            for (int o = 1; o < 8; o <<= 1) s += __shfl_xor(s, o);
            const float mean = s * (1.f / 64.f);
            float q = 0.f;
#pragma unroll
            for (int e = 0; e < 8; ++e) { x[e] -= mean; q += x[e] * x[e]; }
#pragma unroll
            for (int o = 1; o < 8; o <<= 1) q += __shfl_xor(q, o);
            const float rs = rsqrtf(q * (1.f / 64.f) + 64e-5f);
            float g[8];
#pragma unroll
            for (int e = 0; e < 8; ++e) g[e] = 0.f;
            for (int i = 0; i < 128; ++i) {
                const float gi = gl[i];
                const float4 u0 = *(const float4*)(g_up + i * 512 + c0), u1 = *(const float4*)(g_up + i * 512 + c0 + 4);
                g[0] += gi * u0.x; g[1] += gi * u0.y; g[2] += gi * u0.z; g[3] += gi * u0.w; g[4] += gi * u1.x; g[5] += gi * u1.y; g[6] += gi * u1.z; g[7] += gi * u1.w;
            }
            float y[8];
            float vb[8]; unpack8(*(const uint4*)(P + r * PLD + 2064 + 1024 + c0), vb);
            const float rk = RK[(size_t)hd * M_ROWS + r];
#pragma unroll
            for (int e = 0; e < 8; ++e) y[e] = (x[e] * rs * ln_w[c0 + e] + ln_b[c0 + e] + rk * vb[e]) * g[e];
            uint4 w; w.x = pg8::cvt_pk_bf16(y[0], y[1]); w.y = pg8::cvt_pk_bf16(y[2], y[3]); w.z = pg8::cvt_pk_bf16(y[4], y[5]); w.w = pg8::cvt_pk_bf16(y[6], y[7]);
            *(uint4*)(Y + r * 1024 + 512 + c0) = w;
        }
        asm volatile("s_waitcnt lgkmcnt(0)" ::: "memory");
    }
}

typedef __attribute__((address_space(3))) bf16_t lbf16;
typedef __attribute__((address_space(3))) float lf32;
typedef short bf16x8_t __attribute__((ext_vector_type(8)));
typedef float f32x4_t __attribute__((ext_vector_type(4)));
typedef unsigned u32x2_t __attribute__((ext_vector_type(2)));
typedef unsigned u32x4_t __attribute__((ext_vector_type(4)));
DEV bf16_t f2bf_fast(float f) { return (bf16_t)(pg8::cvt_pk_bf16(f, 0.f) & 0xffffu); }
template <int K>
DEV f32x4_t mma16(f32x4_t acc, const lbf16* A, int lda, const lbf16* B, int ldb, int lane) {
    const lbf16* ap = A + (lane & 15) * lda + (lane >> 4) * 8;
    const lbf16* bp = B + (lane & 15) * ldb + (lane >> 4) * 8;
    bf16x8_t a[K / 32], b[K / 32];
#pragma unroll
    for (int k = 0; k < K / 32; ++k) { a[k] = *(const __attribute__((address_space(3))) bf16x8_t*)(ap + 32 * k); b[k] = *(const __attribute__((address_space(3))) bf16x8_t*)(bp + 32 * k); }
    __builtin_amdgcn_sched_barrier(0);
#pragma unroll
    for (int k = 0; k < K / 32; ++k) acc = __builtin_amdgcn_mfma_f32_16x16x32_bf16(a[k], b[k], acc, 0, 0, 0);
    return acc;
}
typedef short s16x4_t __attribute__((ext_vector_type(4)));
DEV bf16x8_t frag_tr(const lbf16* src, int S, int k0, int n0, int lane) {
    const int g = lane >> 4, i = lane & 15;
    const lbf16* p = src + (k0 + 8 * g + (i >> 2)) * S + n0 + 4 * (i & 3);
    const s16x4_t lo = __builtin_amdgcn_ds_read_tr16_b64_v4i16((__attribute__((address_space(3))) s16x4_t*)p);
    const s16x4_t hi = __builtin_amdgcn_ds_read_tr16_b64_v4i16((__attribute__((address_space(3))) s16x4_t*)(p + 4 * S));
    bf16x8_t r; r[0] = lo[0]; r[1] = lo[1]; r[2] = lo[2]; r[3] = lo[3]; r[4] = hi[0]; r[5] = hi[1]; r[6] = hi[2]; r[7] = hi[3];
    return r;
}
DEV bf16x8_t frag_row(const lbf16* M, int ld, int k0, int lane) { return *(const __attribute__((address_space(3))) bf16x8_t*)(M + (lane & 15) * ld + (lane >> 4) * 8 + k0); }
template <int K>
DEV f32x4_t mma16_tA(f32x4_t acc, const lbf16* At, int sa, int i0, const lbf16* B, int ldb, int lane) {
    bf16x8_t a[K / 32], b[K / 32];
#pragma unroll
    for (int k = 0; k < K / 32; ++k) { a[k] = frag_tr(At, sa, 32 * k, i0, lane); b[k] = frag_row(B, ldb, 32 * k, lane); }
    __builtin_amdgcn_sched_barrier(0);
#pragma unroll
    for (int k = 0; k < K / 32; ++k) acc = __builtin_amdgcn_mfma_f32_16x16x32_bf16(a[k], b[k], acc, 0, 0, 0);
    return acc;
}
template <int K>
DEV f32x4_t mma16_tB(f32x4_t acc, const lbf16* A, int lda, const lbf16* Bt, int sb, int j0, int lane) {
    bf16x8_t a[K / 32], b[K / 32];
#pragma unroll
    for (int k = 0; k < K / 32; ++k) { a[k] = frag_row(A, lda, 32 * k, lane); b[k] = frag_tr(Bt, sb, 32 * k, j0, lane); }
    __builtin_amdgcn_sched_barrier(0);
#pragma unroll
    for (int k = 0; k < K / 32; ++k) acc = __builtin_amdgcn_mfma_f32_16x16x32_bf16(a[k], b[k], acc, 0, 0, 0);
    return acc;
}
template <int K>
DEV f32x4_t mma16_tAB(f32x4_t acc, const lbf16* At, int sa, int i0, const lbf16* Bt, int sb, int j0, int lane) {
    bf16x8_t a[K / 32], b[K / 32];
#pragma unroll
    for (int k = 0; k < K / 32; ++k) { a[k] = frag_tr(At, sa, 32 * k, i0, lane); b[k] = frag_tr(Bt, sb, 32 * k, j0, lane); }
    __builtin_amdgcn_sched_barrier(0);
#pragma unroll
    for (int k = 0; k < K / 32; ++k) acc = __builtin_amdgcn_mfma_f32_16x16x32_bf16(a[k], b[k], acc, 0, 0, 0);
    return acc;
}
template <int K>
DEV void mma16_2A(f32x4_t& acc0, f32x4_t& acc1, const lbf16* A0, const lbf16* A1, int lda, const lbf16* B, int ldb, int lane) {
    bf16x8_t a0[K / 32], a1[K / 32], b[K / 32];
#pragma unroll
    for (int k = 0; k < K / 32; ++k) { b[k] = frag_row(B, ldb, 32 * k, lane); a0[k] = frag_row(A0, lda, 32 * k, lane); a1[k] = frag_row(A1, lda, 32 * k, lane); }
    __builtin_amdgcn_sched_barrier(0);
#pragma unroll
    for (int k = 0; k < K / 32; ++k) { acc0 = __builtin_amdgcn_mfma_f32_16x16x32_bf16(a0[k], b[k], acc0, 0, 0, 0); acc1 = __builtin_amdgcn_mfma_f32_16x16x32_bf16(a1[k], b[k], acc1, 0, 0, 0); }
}
template <int K>
DEV void mma16_tAB_2B(f32x4_t& acc0, f32x4_t& acc1, const lbf16* At, int sa, int i0, const lbf16* Bt, int sb, int j00, int j01, int lane) {
    bf16x8_t a[K / 32], b0[K / 32], b1[K / 32];
#pragma unroll
    for (int k = 0; k < K / 32; ++k) { a[k] = frag_tr(At, sa, 32 * k, i0, lane); b0[k] = frag_tr(Bt, sb, 32 * k, j00, lane); b1[k] = frag_tr(Bt, sb, 32 * k, j01, lane); }
    __builtin_amdgcn_sched_barrier(0);
#pragma unroll
    for (int k = 0; k < K / 32; ++k) { acc0 = __builtin_amdgcn_mfma_f32_16x16x32_bf16(a[k], b0[k], acc0, 0, 0, 0); acc1 = __builtin_amdgcn_mfma_f32_16x16x32_bf16(a[k], b1[k], acc1, 0, 0, 0); }
}
DEV void st4_bf16(lbf16* dst, f32x4_t v) { u32x2_t w; w.x = pg8::cvt_pk_bf16(v[0], v[1]); w.y = pg8::cvt_pk_bf16(v[2], v[3]); *(__attribute__((address_space(3))) u32x2_t*)dst = w; }
DEV void st16_lds(lbf16* dst, const uint4 v) { u32x4_t w; w.x = v.x; w.y = v.y; w.z = v.z; w.w = v.w; *(__attribute__((address_space(3))) u32x4_t*)dst = w; }
template <int CTRL, int RMASK> DEV float dpp_src(float ident, float v) { return __builtin_bit_cast(float, __builtin_amdgcn_update_dpp(__builtin_bit_cast(int, ident), __builtin_bit_cast(int, v), CTRL, RMASK, 0xF, false)); }
DEV float wave_incl_scan_add(float v, int) {
    v += dpp_src<0x111, 0xF>(0.f, v); v += dpp_src<0x112, 0xF>(0.f, v); v += dpp_src<0x114, 0xF>(0.f, v); v += dpp_src<0x118, 0xF>(0.f, v);
    v += dpp_src<0x142, 0xA>(0.f, v); v += dpp_src<0x143, 0xC>(0.f, v);
    return v;
}
DEV float wave_incl_scan_max(float v, int) {
    const float ninf = -__builtin_inff();
    v = fmaxf(v, dpp_src<0x111, 0xF>(ninf, v)); v = fmaxf(v, dpp_src<0x112, 0xF>(ninf, v)); v = fmaxf(v, dpp_src<0x114, 0xF>(ninf, v)); v = fmaxf(v, dpp_src<0x118, 0xF>(ninf, v));
    v = fmaxf(v, dpp_src<0x142, 0xA>(ninf, v)); v = fmaxf(v, dpp_src<0x143, 0xC>(ninf, v));
    return v;
}
DEV void phase_localmix(bf16_t* P, int ld, int gemm_n, const bf16_t* HALO, int ca_lo, int ca_n, const float* cw, const float* cb, int sb_lo, int sb_n, const float* mu, int tid, int blk, int G) {
    pg8::StaticOrder S; S.init(M_ROWS, gemm_n, G, blk);
    pg8::Unit u;
    const int cg = tid & 31, rg = (tid >> 5) & 7, chh = tid >> 8;
    for (int it = 0; S.next(it, u); ++it) {
        const int col = u.pn * 256 + 8 * cg;
        const int mode = (col >= ca_lo && col < ca_lo + ca_n) ? 0 : ((col >= sb_lo && col < sb_lo + sb_n) ? 1 : 2);
        const bool valid = mode != 2;
        const int chan = mode == 0 ? col - ca_lo : col - sb_lo;
        float wv[3][8], bv[8];
        if (valid) {
#pragma unroll
            for (int e = 0; e < 8; ++e) {
                if (mode == 0) { wv[0][e] = cw[chan + e]; wv[1][e] = cw[ca_n + chan + e]; wv[2][e] = cw[2 * ca_n + chan + e]; bv[e] = cb[chan + e]; }
                else { wv[0][e] = mu[chan + e]; wv[1][e] = 0.f; wv[2][e] = 0.f; bv[e] = 0.f; }
            }
        }
        for (int cp = 0; cp < 2; ++cp) {
            const int c = u.pm * 4 + cp * 2 + chh;
            const bool first = (c < 128) ? ((c & 3) == 0) : (((c - 128) & 63) == 0);
            const bool last = (c < 128) ? ((c & 3) == 3) : (((c - 128) & 63) == 63);
            uint4 raw[10];
            if (valid) {
#pragma unroll
                for (int rr = 0; rr < 10; ++rr) {
                    const int ri = 8 * rg + rr - 1;
                    const bool lo = ri < 0, hi = ri > 63;
                    const int hc = lo ? (c > 0 ? c - 1 : 0) : (c < 255 ? c + 1 : 255);
                    const bf16_t* src = (lo || hi) ? HALO + (size_t)(hc * 2 + (lo ? 1 : 0)) * ld + col : P + (size_t)(64 * c + ri) * ld + col;
                    uint4 v = *(const uint4*)src;
                    if ((lo && first) || (hi && last)) v = make_uint4(0u, 0u, 0u, 0u);
                    raw[rr] = v;
                }
            }
            asm volatile("s_waitcnt vmcnt(0)" ::: "memory");
            __syncthreads();
            if (valid) {
                float prev[8], cur[8], nxt[8];
                unpack8(raw[0], prev); unpack8(raw[1], cur);
#pragma unroll
                for (int rr = 0; rr < 8; ++rr) {
                    unpack8(raw[rr + 2], nxt);
                    float o[8];
#pragma unroll
                    for (int e = 0; e < 8; ++e) {
                        if (mode == 0) o[e] = siluf_(bv[e] + wv[0][e] * prev[e] + wv[1][e] * cur[e] + wv[2][e] * nxt[e]);
                        else o[e] = cur[e] + wv[0][e] * (0.5f * (prev[e] + nxt[e]) - cur[e]);
                    }
                    *(uint4*)(P + (size_t)(64 * c + 8 * rg + rr) * ld + col) = pack8(o);
#pragma unroll
                    for (int e = 0; e < 8; ++e) { prev[e] = cur[e]; cur[e] = nxt[e]; }
                }
            }
        }
    }
}

DEV void phase_mix_edges(bf16_t* P, int ld, const float* H2, int ca_lo, int ca_n, const float* cw, const float* cb, int sb_lo, int sb_n, const float* mu, int tid, int blk, int G) {
    pg8::StaticOrder S; S.init(M_ROWS, 4096, G, blk);
    pg8::Unit u;
    for (int it = 0; S.next(it, u); ++it) {
        const int T = u.pm >= 32 ? u.pm - 32 : 0, j = T & 15, bot = tid >> 8, col = u.pn * 256 + (tid & 255);
        const bool interior = u.pm >= 32 && (bot ? j < 15 : j > 0);
        const int mode = (col >= ca_lo && col < ca_lo + ca_n) ? 0 : ((col >= sb_lo && col < sb_lo + sb_n) ? 1 : 2);
        const int Tp = bot ? T : (T > 0 ? T - 1 : 0), Tn = bot ? (T < 31 ? T + 1 : 31) : T;
        const float pv = H2[((size_t)Tp * 4 + (bot ? 2 : 3)) * 4096 + col];
        const float cv = H2[((size_t)T * 4 + (bot ? 3 : 0)) * 4096 + col];
        const float nv = H2[((size_t)Tn * 4 + (bot ? 0 : 1)) * 4096 + col];
        const int ch = mode == 0 ? col - ca_lo : 0, sh = mode == 1 ? col - sb_lo : 0;
        const float a0 = cw[ch], a1 = cw[ca_n + ch], a2 = cw[2 * ca_n + ch], ab = cb[ch], m0 = mu[sh];
        const float x = ab + a0 * pv + a1 * cv + a2 * nv;
        const float o = mode == 0 ? x * __builtin_amdgcn_rcpf(1.f + __expf(-x)) : cv + m0 * (0.5f * (pv + nv) - cv);
        if (interior && mode != 2) P[(size_t)(u.pm * 256 + (bot ? 255 : 0)) * ld + col] = f2bf(o);
    }
}

DEV void stage_mix_weights(unsigned char* lds_, int gemm_n, int ca_lo, int ca_n, const float* cw, const float* cb, int sb_lo, int sb_n, const float* mu, int tid, int blk, int G) {
    lf32* wl = (lf32*)(lds_ + pg8::STAGE_BYTES) + 2048; __attribute__((address_space(3))) int* sop = (__attribute__((address_space(3))) int*)((lf32*)(lds_ + pg8::STAGE_BYTES) + 6144);
    pg8::StaticOrder S; S.init(M_ROWS, gemm_n, G, blk);
    pg8::Unit u;
    for (int i = 0; i < 4 && S.next(i, u); ++i) {
        if (tid == 0) sop[u.pn] = i;
        for (int cc = tid; cc < 256; cc += 512) {
            const int col = u.pn * 256 + cc;
            const bool conv = col >= ca_lo && col < ca_lo + ca_n, shf = col >= sb_lo && col < sb_lo + sb_n;
            const int ch = conv ? col - ca_lo : 0, sh = shf ? col - sb_lo : 0;
            const float a0 = cw[ch], a1 = cw[ca_n + ch], a2 = cw[2 * ca_n + ch], ab = cb[ch], m0 = mu[sh];
            wl[(i * 4 + 0) * 256 + cc] = conv ? a0 : (shf ? m0 : 0.f); wl[(i * 4 + 1) * 256 + cc] = conv ? a1 : 0.f; wl[(i * 4 + 2) * 256 + cc] = conv ? a2 : 0.f; wl[(i * 4 + 3) * 256 + cc] = conv ? ab : 0.f;
        }
    }
    __syncthreads();
}

DEV void phase_dt(const bf16_t* H, const bf16_t* Wdt, float* DT, unsigned char* lds_, int tid, int blk, int G) {
    lbf16* Wl = (lbf16*)lds_; lf32* Pr = (lf32*)(lds_ + 64 * 1032 * 2);
    const int lane = tid & 63, wave = tid >> 6, l15 = lane & 15, g8 = (lane >> 4) * 8, tr = wave & 3, kh = wave >> 2;
    for (int rt = blk; rt < M_ROWS / 64; rt += G) {
        const bf16_t* hp = H + (size_t)(64 * rt + 16 * tr + l15) * 1024 + 512 * kh + g8;
        bf16x8_t hb[16];
#pragma unroll
        for (int u = 0; u < 16; ++u) hb[u] = *(const bf16x8_t*)(hp + 32 * u);
        uint4 wst[16];
#pragma unroll
        for (int i = 0; i < 16; ++i) { const int idx = tid + 512 * i; wst[i] = *(const uint4*)(Wdt + (size_t)(idx >> 7) * 1024 + (idx & 127) * 8); }
#pragma unroll
        for (int i = 0; i < 16; ++i) { const int idx = tid + 512 * i; st16_lds(Wl + (idx >> 7) * 1032 + (idx & 127) * 8, wst[i]); }
        __syncthreads();
        f32x4_t acc[4];
#pragma unroll
        for (int tc = 0; tc < 4; ++tc) acc[tc] = (f32x4_t){0.f, 0.f, 0.f, 0.f};
#pragma unroll
        for (int u = 0; u < 16; ++u)
#pragma unroll
            for (int tc = 0; tc < 4; ++tc) {
                const bf16x8_t wf = *(const __attribute__((address_space(3))) bf16x8_t*)(Wl + (16 * tc + l15) * 1032 + 512 * kh + 32 * u + g8);
                acc[tc] = __builtin_amdgcn_mfma_f32_16x16x32_bf16(wf, hb[u], acc[tc], 0, 0, 0);
            }
        if (kh == 1) {
#pragma unroll
            for (int tc = 0; tc < 4; ++tc) *(__attribute__((address_space(3))) f32x4_t*)(Pr + ((tr * 4 + tc) * 64 + lane) * 4) = acc[tc];
        }
        __syncthreads();
        if (kh == 0) {
            float* dp = DT + (size_t)(64 * rt + 16 * tr + l15) * 64 + 4 * (lane >> 4);
#pragma unroll
            for (int tc = 0; tc < 4; ++tc) { const f32x4_t p = *(const __attribute__((address_space(3))) f32x4_t*)(Pr + ((tr * 4 + tc) * 64 + lane) * 4); *(f32x4_t*)(dp + 16 * tc) = acc[tc] + p; }
        }
        __syncthreads();
    }
}

constexpr int SS_CM = 0, SS_BM = 17408, SS_XA = 34816, SS_XB = 39936, SS_W = 45056, SS_SBF = 54272, SS_SET = 62976;
constexpr int SS2_XA = 34816, SS2_XB = 44032, SS2_W = 53248, SS2_SBF = 62464, SS2_SET = 79872;
template <int NP>
DEV void job_ssd_chunked(const int sid, const int h, const int ph, unsigned char* lds_, int tid, const bf16_t* XBC, const float* DT, const float* dt_bias, const float* a_log,
                         const float* dskip, const float* s0, bf16_t* YS, float* out_s) {
    constexpr int SET = NP == 1 ? SS_SET : SS2_SET, OXA = NP == 1 ? SS_XA : SS2_XA, OXB = NP == 1 ? SS_XB : SS2_XB, OW = NP == 1 ? SS_W : SS2_W, OSBF = NP == 1 ? SS_SBF : SS2_SBF, XS = NP == 1 ? 40 : 72, CS = NP == 1 ? 4096 : 256;
    lf32* cumT = (lf32*)(lds_ + 2 * SET);
    int row0, T; seq_info(sid, row0, T);
    const int nc = T >> 6, g = h >> 2, lane = tid & 63, wave = tid >> 6, q4 = (lane >> 4) * 4, l15 = lane & 15;
    const int p0 = NP == 1 ? 32 * ph : 0;
    f32x4_t S[2][2 * NP];
    float inv_a[2];
#pragma unroll
    for (int d = 0; d < 2; ++d) {
        inv_a[d] = -__expf(-a_log[d * 32 + h]);
#pragma unroll
        for (int tp = 0; tp < 2 * NP; ++tp) {
            if (sid >= 32) S[d][tp] = *(const f32x4_t*)(s0 + ((size_t)((sid - 32) * 2 + d) * 32 + h) * 8192 + (size_t)(p0 + 16 * tp + l15) * 128 + 16 * wave + q4);
            else S[d][tp] = (f32x4_t){0.f, 0.f, 0.f, 0.f};
        }
    }
    const float dsk = dskip[h];
    {
        const int dd = wave & 1;
        const float bias = dt_bias[dd * 32 + h], a_d = -__expf(a_log[dd * 32 + h]);
        if (nc == 64) {
            float dv[16];
#pragma unroll
            for (int k = 0; k < 16; ++k) { const int step = (wave + 8 * k) >> 1, cidx = dd ? nc - 1 - step : step; dv[k] = DT[(size_t)(row0 + 64 * cidx + (dd ? 63 - lane : lane)) * 64 + dd * 32 + h]; }
#pragma unroll
            for (int k = 0; k < 16; ++k) { const int step = (wave + 8 * k) >> 1; cumT[dd * CS + 64 * step + lane] = wave_incl_scan_add(softplusf_(dv[k] + bias) * a_d, lane); }
        } else {
            for (int item = wave; item < 2 * nc; item += 8) {
                const int step = item >> 1, cidx = dd ? nc - 1 - step : step;
                const size_t row = (size_t)(row0 + 64 * cidx + (dd ? 63 - lane : lane));
                cumT[dd * CS + 64 * step + lane] = wave_incl_scan_add(softplusf_(DT[row * 64 + dd * 32 + h] + bias) * a_d, lane);
            }
        }
    }
    __syncthreads();
    const int o_tt = wave >> 1, o_t = 16 * o_tt + l15;
    for (int step = 0; step < nc; ++step) {
        const bool first = step < (nc >> 1);
        uint4 pc0[2], pb0[2], pc1[2], pb1[2], px[2];
#pragma unroll
        for (int d = 0; d < 2; ++d) {
            const int rbase = row0 + 64 * (d ? nc - 1 - step : step);
            const int j = tid >> 4, c8 = tid & 15;
            const size_t r0 = (size_t)(rbase + (d ? 63 - j : j)), r1 = (size_t)(rbase + (d ? 31 - j : 32 + j));
            pc0[d] = *(const uint4*)(XBC + r0 * P2LD + 3072 + 128 * g + 8 * c8); pb0[d] = *(const uint4*)(XBC + r0 * P2LD + 2048 + 128 * g + 8 * c8);
            pc1[d] = *(const uint4*)(XBC + r1 * P2LD + 3072 + 128 * g + 8 * c8); pb1[d] = *(const uint4*)(XBC + r1 * P2LD + 2048 + 128 * g + 8 * c8);
            const int jx = NP == 1 ? (tid & 255) >> 2 : tid >> 3, cx = NP == 1 ? (tid & 3) : (tid & 7);
            px[d] = *(const uint4*)(XBC + (size_t)(rbase + (d ? 63 - jx : jx)) * P2LD + 64 * h + p0 + 8 * cx);
        }
#pragma unroll
        for (int d = 0; d < 2; ++d) {
            unsigned char* base = lds_ + d * SET;
            lbf16* Cm = (lbf16*)(base + SS_CM); lbf16* Bm = (lbf16*)(base + SS_BM); lbf16* Xa = (lbf16*)(base + OXA); lbf16* Xb = (lbf16*)(base + OXB); lbf16* Sbf = (lbf16*)(base + OSBF);
            const lf32* cumL = cumT + d * CS + 64 * step;
#pragma unroll
            for (int tp = 0; tp < 2 * NP; ++tp) st4_bf16(Sbf + (16 * tp + l15) * 136 + 16 * wave + q4, S[d][tp]);
            const float cend = cumL[63];
            {
                const int j = tid >> 4, c8 = tid & 15;
                st16_lds(Cm + j * 136 + 8 * c8, pc0[d]); st16_lds(Bm + j * 136 + 8 * c8, pb0[d]);
                st16_lds(Cm + (32 + j) * 136 + 8 * c8, pc1[d]); st16_lds(Bm + (32 + j) * 136 + 8 * c8, pb1[d]);
            }
            if (NP == 2 || (tid >> 8) == d) {
                const int j = NP == 1 ? (tid & 255) >> 2 : tid >> 3, c8 = NP == 1 ? (tid & 3) : (tid & 7);
                float xf[8], xg[8]; unpack8(px[d], xf);
                const float cj = cumL[j], cp = j ? cumL[j - 1] : 0.f;
                const float dtv = (cj - cp) * inv_a[d], dtd = dtv * __expf(cend - cj);
#pragma unroll
                for (int e = 0; e < 8; ++e) { xg[e] = xf[e] * dtd; xf[e] *= dtv; }
                st16_lds(Xa + j * XS + 8 * c8, pack8(xf));
                st16_lds(Xb + j * XS + 8 * c8, pack8(xg));
            }
        }
        asm volatile("s_waitcnt vmcnt(0)" ::: "memory");
        __syncthreads();
        uint2 yrd[2][NP], xrd[NP];
        bf16_t* ypd[2][NP];
#pragma unroll
        for (int d = 0; d < 2; ++d) {
            const int rbase = row0 + 64 * (d ? nc - 1 - step : step);
            const size_t row = (size_t)(rbase + (d ? 63 - o_t : o_t));
#pragma unroll
            for (int i = 0; i < NP; ++i) {
                const int o_tp = NP * (wave & 1) + i, phi = NP == 1 ? ph : (o_tp >> 1);
                ypd[d][i] = YS + ((size_t)(phi * 32 + h) * M_ROWS + row) * 32 + 16 * (o_tp & 1) + q4;
                const bf16_t* xsrc = XBC + row * P2LD + 64 * h + p0 + 16 * o_tp + q4;
                yrd[d][i] = *(const uint2*)(first ? xsrc : (const bf16_t*)ypd[d][i]);
                if (d == 0) xrd[i] = *(const uint2*)xsrc;
            }
        }
#pragma unroll
        for (int d = 0; d < 2; ++d) {
            unsigned char* base = lds_ + d * SET;
            lbf16* Cm = (lbf16*)(base + SS_CM); lbf16* Bm = (lbf16*)(base + SS_BM); lbf16* Wm = (lbf16*)(base + OW);
            const lf32* cumL = cumT + d * CS + 64 * step;
            {
                const int tt = wave >> 1, ts0 = 2 * (wave & 1);
                f32x4_t accs[2]; accs[0] = (f32x4_t){0.f, 0.f, 0.f, 0.f}; accs[1] = accs[0];
                if (ts0 <= tt) mma16_2A<128>(accs[0], accs[1], Bm + ts0 * 16 * 136, Bm + (ts0 + 1) * 16 * 136, 136, Cm + tt * 16 * 136, 136, lane);
                const int t = 16 * tt + l15;
                const float ct = cumL[t];
#pragma unroll
                for (int i = 0; i < 2; ++i) {
                    const int sb = 16 * (ts0 + i) + q4;
                    const f32x4_t cs = *(const __attribute__((address_space(3))) f32x4_t*)(cumL + sb);
                    f32x4_t acc = accs[i];
#pragma unroll
                    for (int r = 0; r < 4; ++r) { const float e = __expf(fminf(ct - cs[r], 0.f)); acc[r] = (sb + r <= t) ? acc[r] * e : 0.f; }
                    st4_bf16(Wm + t * 72 + sb, acc);
                }
            }
        }
        __syncthreads();
#pragma unroll
        for (int d = 0; d < 2; ++d) {
            unsigned char* base = lds_ + d * SET;
            lbf16* Cm = (lbf16*)(base + SS_CM); lbf16* Bm = (lbf16*)(base + SS_BM); lbf16* Xa = (lbf16*)(base + OXA); lbf16* Xb = (lbf16*)(base + OXB);
            lbf16* Wm = (lbf16*)(base + OW); lbf16* Sbf = (lbf16*)(base + OSBF);
            const lf32* cumL = cumT + d * CS + 64 * step;
            const int rbase = row0 + 64 * (d ? nc - 1 - step : step);
#pragma unroll
            for (int i = 0; i < NP; ++i) {
                const int o_tp = NP * (wave & 1) + i;
                f32x4_t acc = (f32x4_t){0.f, 0.f, 0.f, 0.f};
                acc = mma16<128>(acc, Sbf + o_tp * 16 * 136, 136, Cm + o_tt * 16 * 136, 136, lane);
                acc *= __expf(cumL[o_t]);
                acc = mma16_tA<64>(acc, Xa, XS, 16 * o_tp, Wm + o_tt * 16 * 72, 72, lane);
                if (d == 0) {
                    acc[0] += dsk * __uint_as_float(xrd[i].x << 16); acc[1] += dsk * __uint_as_float(xrd[i].x & 0xffff0000u);
                    acc[2] += dsk * __uint_as_float(xrd[i].y << 16); acc[3] += dsk * __uint_as_float(xrd[i].y & 0xffff0000u);
                }
                {
                    uint2 yr = yrd[d][i];
                    if (first) yr = make_uint2(0u, 0u);
                    acc[0] += __uint_as_float(yr.x << 16); acc[1] += __uint_as_float(yr.x & 0xffff0000u);
                    acc[2] += __uint_as_float(yr.y << 16); acc[3] += __uint_as_float(yr.y & 0xffff0000u);
                }
                bf16_t* yp = ypd[d][i];
                uint2 w; w.x = pg8::cvt_pk_bf16(acc[0], acc[1]); w.y = pg8::cvt_pk_bf16(acc[2], acc[3]);
                *(uint2*)yp = w;
            }
            {
                const float ee = __expf(cumL[63]);
#pragma unroll
                for (int tp = 0; tp < 2 * NP; ++tp) S[d][tp] *= ee;
#pragma unroll
                for (int gp = 0; gp < NP; ++gp) mma16_tAB_2B<64>(S[d][2 * gp], S[d][2 * gp + 1], Bm, 136, 16 * wave, Xb, XS, 32 * gp, 32 * gp + 16, lane);
            }
        }
        __syncthreads();
    }
    if (sid < 32) {
#pragma unroll
        for (int d = 0; d < 2; ++d)
#pragma unroll
            for (int tp = 0; tp < 2 * NP; ++tp)
                *(f32x4_t*)(out_s + ((size_t)(sid * 2 + d) * 32 + h) * 8192 + (size_t)(p0 + 16 * tp + l15) * 128 + 16 * wave + q4) = S[d][tp];
    }
}

constexpr int S1_CM = 0, S1_BM = 17408, S1_XA = 34816, S1_XB = 44032, S1_W = 53248, S1_SBF = 62464, S1_CUM = 79872;
DEV void job_ssd_1dir(const int sid, const int h, const int d, unsigned char* lds_, int tid, const bf16_t* XBC, const float* DT, const float* dt_bias, const float* a_log,
                      const float* dskip, const float* s0, bf16_t* Yout, const int yrows, const int yrow0) {
    lbf16* Cm = (lbf16*)(lds_ + S1_CM); lbf16* Bm = (lbf16*)(lds_ + S1_BM); lbf16* Xa = (lbf16*)(lds_ + S1_XA); lbf16* Xb = (lbf16*)(lds_ + S1_XB);
    lbf16* Wm = (lbf16*)(lds_ + S1_W); lbf16* Sbf = (lbf16*)(lds_ + S1_SBF); lf32* cumT = (lf32*)(lds_ + S1_CUM);
    int row0, T; seq_info(sid, row0, T);
    const int nc = T >> 6, g = h >> 2, lane = tid & 63, wave = tid >> 6, q4 = (lane >> 4) * 4, l15 = lane & 15;
    f32x4_t S[4];
    const float inv_a = -__expf(-a_log[d * 32 + h]);
#pragma unroll
    for (int tp = 0; tp < 4; ++tp) S[tp] = *(const f32x4_t*)(s0 + ((size_t)((sid - 32) * 2 + d) * 32 + h) * 8192 + (size_t)(16 * tp + l15) * 128 + 16 * wave + q4);
    const float dsk = d == 0 ? dskip[h] : 0.f * dskip[h];
    {
        const float bias = dt_bias[d * 32 + h], a_d = -__expf(a_log[d * 32 + h]);
        float dv[8];
#pragma unroll
        for (int k = 0; k < 8; ++k) { const int step = wave + 8 * k, cidx = d ? nc - 1 - step : step; dv[k] = DT[(size_t)(row0 + 64 * cidx + (d ? 63 - lane : lane)) * 64 + d * 32 + h]; }
#pragma unroll
        for (int k = 0; k < 8; ++k) cumT[64 * (wave + 8 * k) + lane] = wave_incl_scan_add(softplusf_(dv[k] + bias) * a_d, lane);
    }
    __syncthreads();
    const int o_tt = wave >> 1, o_t = 16 * o_tt + l15;
    for (int step = 0; step < nc; ++step) {
        const int rbase = row0 + 64 * (d ? nc - 1 - step : step);
        const lf32* cumL = cumT + 64 * step;
        uint4 pc0, pb0, pc1, pb1, px;
        {
            const int j = tid >> 4, c8 = tid & 15;
            const size_t r0 = (size_t)(rbase + (d ? 63 - j : j)), r1 = (size_t)(rbase + (d ? 31 - j : 32 + j));
            pc0 = *(const uint4*)(XBC + r0 * P2LD + 3072 + 128 * g + 8 * c8); pb0 = *(const uint4*)(XBC + r0 * P2LD + 2048 + 128 * g + 8 * c8);
            pc1 = *(const uint4*)(XBC + r1 * P2LD + 3072 + 128 * g + 8 * c8); pb1 = *(const uint4*)(XBC + r1 * P2LD + 2048 + 128 * g + 8 * c8);
            const int jx = tid >> 3, cx = tid & 7;
            px = *(const uint4*)(XBC + (size_t)(rbase + (d ? 63 - jx : jx)) * P2LD + 64 * h + 8 * cx);
        }
#pragma unroll
        for (int tp = 0; tp < 4; ++tp) st4_bf16(Sbf + (16 * tp + l15) * 136 + 16 * wave + q4, S[tp]);
        const float cend = cumL[63];
        {
            const int j = tid >> 4, c8 = tid & 15;
            st16_lds(Cm + j * 136 + 8 * c8, pc0); st16_lds(Bm + j * 136 + 8 * c8, pb0);
            st16_lds(Cm + (32 + j) * 136 + 8 * c8, pc1); st16_lds(Bm + (32 + j) * 136 + 8 * c8, pb1);
        }
        {
            const int j = tid >> 3, c8 = tid & 7;
            float xf[8], xg[8]; unpack8(px, xf);
            const float cj = cumL[j], cp = j ? cumL[j - 1] : 0.f;
            const float dtv = (cj - cp) * inv_a, dtd = dtv * __expf(cend - cj);
#pragma unroll
            for (int e = 0; e < 8; ++e) { xg[e] = xf[e] * dtd; xf[e] *= dtv; }
            st16_lds(Xa + j * 72 + 8 * c8, pack8(xf));
            st16_lds(Xb + j * 72 + 8 * c8, pack8(xg));
        }
        __syncthreads();
        uint2 xrd[2];
        const size_t orow = (size_t)(rbase + (d ? 63 - o_t : o_t));
#pragma unroll
        for (int i = 0; i < 2; ++i) xrd[i] = *(const uint2*)(XBC + orow * P2LD + 64 * h + 16 * (2 * (wave & 1) + i) + q4);
        {
            const int tt = wave >> 1, ts0 = 2 * (wave & 1);
            f32x4_t accs[2]; accs[0] = (f32x4_t){0.f, 0.f, 0.f, 0.f}; accs[1] = accs[0];
            if (ts0 <= tt) mma16_2A<128>(accs[0], accs[1], Bm + ts0 * 16 * 136, Bm + (ts0 + 1) * 16 * 136, 136, Cm + tt * 16 * 136, 136, lane);
            const int t = 16 * tt + l15;
            const float ct = cumL[t];
#pragma unroll
            for (int i = 0; i < 2; ++i) {
                const int sb = 16 * (ts0 + i) + q4;
                const f32x4_t cs = *(const __attribute__((address_space(3))) f32x4_t*)(cumL + sb);
                f32x4_t acc = accs[i];
#pragma unroll
                for (int r = 0; r < 4; ++r) { const float e = __expf(fminf(ct - cs[r], 0.f)); acc[r] = (sb + r <= t) ? acc[r] * e : 0.f; }
                st4_bf16(Wm + t * 72 + sb, acc);
            }
        }
        __syncthreads();
#pragma unroll
        for (int i = 0; i < 2; ++i) {
            const int o_tp = 2 * (wave & 1) + i;
            f32x4_t acc = (f32x4_t){0.f, 0.f, 0.f, 0.f};
            acc = mma16<128>(acc, Sbf + o_tp * 16 * 136, 136, Cm + o_tt * 16 * 136, 136, lane);
            acc *= __expf(cumL[o_t]);
            acc = mma16_tA<64>(acc, Xa, 72, 16 * o_tp, Wm + o_tt * 16 * 72, 72, lane);
            acc[0] += dsk * __uint_as_float(xrd[i].x << 16); acc[1] += dsk * __uint_as_float(xrd[i].x & 0xffff0000u);
            acc[2] += dsk * __uint_as_float(xrd[i].y << 16); acc[3] += dsk * __uint_as_float(xrd[i].y & 0xffff0000u);
            uint2 w; w.x = pg8::cvt_pk_bf16(acc[0], acc[1]); w.y = pg8::cvt_pk_bf16(acc[2], acc[3]);
            *(uint2*)(Yout + ((size_t)((o_tp >> 1) * 32 + h) * yrows + (orow - yrow0)) * 32 + 16 * (o_tp & 1) + q4) = w;
        }
        {
            const float ee = __expf(cumL[63]);
#pragma unroll
            for (int tp = 0; tp < 4; ++tp) S[tp] *= ee;
#pragma unroll
            for (int gp = 0; gp < 2; ++gp) mma16_tAB_2B<64>(S[2 * gp], S[2 * gp + 1], Bm, 136, 16 * wave, Xb, 72, 32 * gp, 32 * gp + 16, lane);
        }
        __syncthreads();
    }
}

constexpr int ML_QM = 0, ML_KM = 17408, ML_KDT = 34816  , ML_VT = 52224  , ML_SM = 57856, ML_CT = 67072, ML_F32 = 75776, ML_TAB = 77312, ML_VT2 = 131072  , ML_CT2 = 140288  ;
template <int NT>
DEV void job_mlstm_chunked(const int sid, const int h, const int vq, const int d, unsigned char* lds_, int tid, const bf16_t* P, const float* GATES, const float* gate_b,
                           const float* c0, const float* n0, const float* m0, bf16_t* HAD, bf16_t* HAD2, float* out_c, float* out_n, float* out_m) {
    lbf16* Qm = (lbf16*)(lds_ + ML_QM); lbf16* Km = (lbf16*)(lds_ + ML_KM); lbf16* KdT = (lbf16*)(lds_ + ML_KDT); lbf16* VT = (lbf16*)(lds_ + (NT == 1 ? ML_VT : ML_VT2)); constexpr int VS = NT == 1 ? 40 : 72;
    lbf16* Sm = (lbf16*)(lds_ + ML_SM); lbf16* CT = (lbf16*)(lds_ + (NT == 1 ? ML_CT : ML_CT2));
    lf32* denL = (lf32*)(lds_ + ML_F32) + 192; lf32* nL = (lf32*)(lds_ + ML_F32) + 256;
    lf32* uT = (lf32*)(lds_ + ML_TAB); lf32* pmT = uT + 4096; lf32* bT = uT + 8192;
    int row0, T; seq_info(sid, row0, T);
    const int nc = T >> 6, lane = tid & 63, wave = tid >> 6, q4 = (lane >> 4) * 4, l15 = lane & 15;
    const int v0 = 32 * NT * vq;
    f32x4_t C[2 * NT];
    float m_prev = 0.f;
    if (sid >= 32) {
        const size_t base = (size_t)((sid - 32) * 2 + d) * 4 + h;
#pragma unroll
        for (int tv = 0; tv < 2 * NT; ++tv)
#pragma unroll
            for (int r = 0; r < 4; ++r) C[tv][r] = c0[base * 16384 + (size_t)(16 * wave + q4 + r) * 128 + v0 + 16 * tv + l15];
        if (tid < 128) nL[tid] = n0[base * 128 + tid];
        m_prev = m0[base];
    } else {
#pragma unroll
        for (int tv = 0; tv < 2 * NT; ++tv) C[tv] = (f32x4_t){0.f, 0.f, 0.f, 0.f};
        if (tid < 128) nL[tid] = 0.f;
    }
    bf16_t* HADg[NT];
#pragma unroll
    for (int g = 0; g < NT; ++g) HADg[g] = had_slab(HAD, HAD2, (d * 4 + NT * vq + g) * 4 + h);
    {
        const float gbi = gate_b[(0 * 2 + d) * 4 + h], gbf = gate_b[(1 * 2 + d) * 4 + h];
        if (nc == 64) {
            float gi[8], gf[8];
#pragma unroll
            for (int k = 0; k < 8; ++k) { const int step = wave + 8 * k; const size_t row = (size_t)(row0 + 64 * (d ? nc - 1 - step : step) + (d ? 63 - lane : lane));
                gi[k] = GATES[row * 16 + (0 * 2 + d) * 4 + h]; gf[k] = GATES[row * 16 + (1 * 2 + d) * 4 + h]; }
#pragma unroll
            for (int k = 0; k < 8; ++k) { const int step = wave + 8 * k;
                const float b = wave_incl_scan_add(logsigmoidf_(gf[k] + gbf), lane), u = gi[k] + gbi - b;
                uT[64 * step + lane] = u; pmT[64 * step + lane] = wave_incl_scan_max(u, lane); bT[64 * step + lane] = b; }
        } else {
            for (int step = wave; step < nc; step += 8) {
                const size_t row = (size_t)(row0 + 64 * (d ? nc - 1 - step : step) + (d ? 63 - lane : lane));
                const float li = GATES[row * 16 + (0 * 2 + d) * 4 + h] + gbi;
                const float lf = logsigmoidf_(GATES[row * 16 + (1 * 2 + d) * 4 + h] + gbf);
                const float b = wave_incl_scan_add(lf, lane);
                const float u = li - b;
                uT[64 * step + lane] = u; pmT[64 * step + lane] = wave_incl_scan_max(u, lane); bT[64 * step + lane] = b;
            }
        }
    }
    __syncthreads();
    uint4 nq[2], nk[2], nvr;
#define ML_LOADP(stp) do { const int rb_ = row0 + 64 * (d ? nc - 1 - (stp) : (stp)); \
        _Pragma("unroll") for (int i_ = 0; i_ < 2; ++i_) { const int idx_ = tid + 512 * i_, j_ = idx_ >> 4, c8_ = idx_ & 15; const size_t row_ = (size_t)(rb_ + (d ? 63 - j_ : j_)); \
            nq[i_] = *(const uint4*)(P + row_ * PLD + 128 * h + 8 * c8_); nk[i_] = *(const uint4*)(P + row_ * PLD + 512 + 128 * h + 8 * c8_); } \
        { const int j_ = NT == 1 ? (tid & 255) >> 2 : tid >> 3, c8_ = NT == 1 ? (tid & 3) : (tid & 7); nvr = *(const uint4*)(P + (size_t)(rb_ + (d ? 63 - j_ : j_)) * PLD + 1024 + 128 * h + v0 + 8 * c8_); } } while (0)
    ML_LOADP(0);
    for (int step = 0; step < nc; ++step) {
        const int cidx = d ? nc - 1 - step : step;
        const int rbase = row0 + 64 * cidx;
        const lf32* uL = uT + 64 * step; const lf32* pmL = pmT + 64 * step; const lf32* bL = bT + 64 * step;
#pragma unroll
        for (int tv = 0; tv < 2 * NT; ++tv) st4_bf16(CT + (16 * tv + l15) * 136 + 16 * wave + q4, C[tv]);
        const float Mend = fmaxf(m_prev, pmL[63]);
#pragma unroll
        for (int i = 0; i < 2; ++i) {
            const int idx = tid + 512 * i, j = idx >> 4, c8 = idx & 15;
            const uint4 qr = nq[i];
            const uint4 kr = nk[i];
            st16_lds(Qm + j * 136 + 8 * c8, qr);
            float kf[8]; unpack8(kr, kf);
#pragma unroll
            for (int e = 0; e < 8; ++e) kf[e] *= 0.08838834764831845f;
            st16_lds(Km + j * 136 + 8 * c8, pack8(kf));
            const float sc = __expf(uL[j] - Mend);
#pragma unroll
            for (int e = 0; e < 8; ++e) kf[e] *= sc;
            st16_lds(KdT + j * 136 + 8 * c8, pack8(kf));
        }
        {
            const int j = NT == 1 ? (tid & 255) >> 2 : tid >> 3, c8 = NT == 1 ? (tid & 3) : (tid & 7);
            st16_lds(VT + j * VS + 8 * c8, nvr);
        }
        __syncthreads();
        { const int nstep = step + 1 < nc ? step + 1 : step; ML_LOADP(nstep); }
        {
            const int tt = wave >> 1, ts0 = 2 * (wave & 1);
            f32x4_t accs[2]; accs[0] = (f32x4_t){0.f, 0.f, 0.f, 0.f}; accs[1] = accs[0];
            if (ts0 <= tt) mma16_2A<128>(accs[0], accs[1], Km + ts0 * 16 * 136, Km + (ts0 + 1) * 16 * 136, 136, Qm + tt * 16 * 136, 136, lane);
            const int t = 16 * tt + l15;
            const float Mt = fmaxf(m_prev, pmL[t]);
#pragma unroll
            for (int i = 0; i < 2; ++i) {
                const int sb = 16 * (ts0 + i) + q4;
                const f32x4_t us = *(const __attribute__((address_space(3))) f32x4_t*)(uL + sb);
                f32x4_t acc = accs[i];
#pragma unroll
                for (int r = 0; r < 4; ++r) { const float e = __expf(fminf(us[r] - Mt, 0.f)); acc[r] = (sb + r <= t) ? acc[r] * e : 0.f; }
                st4_bf16(Sm + t * 72 + sb, acc);
            }
        }
        __syncthreads();
        {
            const int t = tid >> 3, part = tid & 7;
            float ssum = 0.f, qn = 0.f;
            {
                float sf[8]; const u32x4_t sr = *(const __attribute__((address_space(3))) u32x4_t*)(Sm + t * 72 + part * 8);
                uint4 s4; s4.x = sr.x; s4.y = sr.y; s4.z = sr.z; s4.w = sr.w; unpack8(s4, sf);
#pragma unroll
                for (int e = 0; e < 8; ++e) ssum += sf[e];
#pragma unroll
                for (int hh = 0; hh < 2; ++hh) {
                    float qf[8]; const u32x4_t qr = *(const __attribute__((address_space(3))) u32x4_t*)(Qm + t * 136 + part * 16 + 8 * hh);
                    uint4 q4v; q4v.x = qr.x; q4v.y = qr.y; q4v.z = qr.z; q4v.w = qr.w; unpack8(q4v, qf);
                    const f32x4_t n0 = *(const __attribute__((address_space(3))) f32x4_t*)(nL + part * 16 + 8 * hh), n1 = *(const __attribute__((address_space(3))) f32x4_t*)(nL + part * 16 + 8 * hh + 4);
                    qn += qf[0] * n0[0] + qf[1] * n0[1] + qf[2] * n0[2] + qf[3] * n0[3] + qf[4] * n1[0] + qf[5] * n1[1] + qf[6] * n1[2] + qf[7] * n1[3];
                }
            }
            float tot = ssum + __expf(m_prev - fmaxf(m_prev, pmL[t])) * qn;
            tot += __shfl_xor(tot, 1); tot += __shfl_xor(tot, 2); tot += __shfl_xor(tot, 4);
            if (part == 0) denL[t] = tot;
        }
        __syncthreads();
#pragma unroll
        for (int i = 0; i < NT; ++i) {
            const int tt = wave >> 1, tv = NT * (wave & 1) + i;
            f32x4_t acc = (f32x4_t){0.f, 0.f, 0.f, 0.f};
            acc = mma16<128>(acc, CT + tv * 16 * 136, 136, Qm + tt * 16 * 136, 136, lane);
            const int t = 16 * tt + l15;
            const float Mt = fmaxf(m_prev, pmL[t]);
            acc *= __expf(m_prev - Mt);
            acc = mma16_tA<64>(acc, VT, VS, 16 * tv, Sm + tt * 16 * 72, 72, lane);
            const float dn = fmaxf(fabsf(denL[t]), __expf(-(bL[t] + Mt)));
            const float inv = __builtin_amdgcn_rcpf(dn);
            acc *= inv;
            const size_t row = (size_t)(rbase + (d ? 63 - t : t));
            uint2 w; w.x = pg8::cvt_pk_bf16(acc[0], acc[1]); w.y = pg8::cvt_pk_bf16(acc[2], acc[3]);
            *(uint2*)(HADg[tv >> 1] + row * 32 + 16 * (tv & 1) + q4) = w;
        }
        {
            const float fC = __expf(m_prev - Mend);
#pragma unroll
            for (int tv = 0; tv < 2 * NT; ++tv) C[tv] *= fC;
#pragma unroll
            for (int g = 0; g < NT; ++g) mma16_tAB_2B<64>(C[2 * g], C[2 * g + 1], KdT, 136, 16 * wave, VT, VS, 32 * g, 32 * g + 16, lane);
            const int k = tid >> 2, part = tid & 3;
            float ks = 0.f;
#pragma unroll
            for (int e = 0; e < 16; ++e) ks += bf2f(KdT[(part * 16 + e) * 136 + k]);
            ks += __shfl_xor(ks, 1); ks += __shfl_xor(ks, 2);
            if (part == 0) nL[k] = fC * nL[k] + ks;
        }
        m_prev = bL[63] + Mend;
        __syncthreads();
    }
    if (sid < 32) {
        const size_t base = (size_t)(sid * 2 + d) * 4 + h;
#pragma unroll
        for (int tv = 0; tv < 2 * NT; ++tv)
#pragma unroll
            for (int r = 0; r < 4; ++r) out_c[base * 16384 + (size_t)(16 * wave + q4 + r) * 128 + v0 + 16 * tv + l15] = C[tv][r];
        if (vq == 0) {
            if (tid < 128) out_n[base * 128 + tid] = nL[tid];
            if (tid == 0) out_m[base] = m_prev;
        }
    }
}

DEV int zrow_of(int sid, int d, int row) { const int t = (row - 8192) & 4095; return (sid - 32) * 2048 + (d ? t : t - 2048); }
DEV void job_rwkv_fixup(const int sid, const int hd, const int d, const int cg, unsigned char* lds_, int tid, const float* SMID, const bf16_t* ZB, const bf16_t* YBD, bf16_t* YBD2) {
    lbf16* Sb = (lbf16*)(lds_); lbf16* Zt = (lbf16*)(lds_ + 9216);
    const int lane = tid & 63, wave = tid >> 6, q4 = (lane >> 4) * 4, l15 = lane & 15;
    int row0, T; seq_info(sid, row0, T);
    const int nc = T >> 6;
    {
        const int v = tid >> 3, k8 = (tid & 7) * 8;
        const float* sp = SMID + ((size_t)((sid - 32) * 2 + d) * 8 + hd) * 4096 + v * 64 + k8;
        float f[8];
#pragma unroll
        for (int e = 0; e < 8; ++e) f[e] = sp[e];
        st16_lds(Sb + v * 72 + k8, pack8(f));
    }
    YBD += ((size_t)(d * 8 + hd) * M_ROWS) * 64; YBD2 += ((size_t)(d * 8 + hd) * M_ROWS) * 64;
    const int st0 = (nc >> 1) + 4 * cg, tt = wave >> 1;
    uint4 zq[4]; uint2 yq[4][2];
#pragma unroll
    for (int k = 0; k < 4; ++k) {
        const int cidx = d ? nc - 1 - (st0 + k) : st0 + k, rbase = row0 + 64 * cidx;
        { const int j = tid >> 3, c8 = (tid & 7) * 8; zq[k] = *(const uint4*)(ZB + ((size_t)(d * 8 + hd) * 4096 + zrow_of(sid, d, rbase + (d ? 63 - j : j))) * 64 + c8); }
#pragma unroll
        for (int i = 0; i < 2; ++i) { const int t = 16 * tt + l15; yq[k][i] = *(const uint2*)(YBD + (size_t)(rbase + (d ? 63 - t : t)) * 64 + 16 * (2 * (wave & 1) + i) + q4); }
    }
#pragma unroll
    for (int k = 0; k < 4; ++k) {
        const int cidx = d ? nc - 1 - (st0 + k) : st0 + k, rbase = row0 + 64 * cidx;
        lbf16* Zc = Zt + ((k & 1) ? 64 * 72 : 0);
        { const int j = tid >> 3, c8 = (tid & 7) * 8; st16_lds(Zc + j * 72 + c8, zq[k]); }
        __syncthreads();
#pragma unroll
        for (int i = 0; i < 2; ++i) {
            const int tv = 2 * (wave & 1) + i;
            f32x4_t acc = (f32x4_t){0.f, 0.f, 0.f, 0.f};
            acc = mma16<64>(acc, Sb + tv * 16 * 72, 72, Zc + tt * 16 * 72, 72, lane);
            const int t = 16 * tt + l15;
            const size_t yo = (size_t)(rbase + (d ? 63 - t : t)) * 64 + 16 * tv + q4;
            const uint2 yr = yq[k][i];
            acc[0] += __uint_as_float(yr.x << 16); acc[1] += __uint_as_float(yr.x & 0xffff0000u);
            acc[2] += __uint_as_float(yr.y << 16); acc[3] += __uint_as_float(yr.y & 0xffff0000u);
            uint2 w; w.x = pg8::cvt_pk_bf16(acc[0], acc[1]); w.y = pg8::cvt_pk_bf16(acc[2], acc[3]);
            *(uint2*)(YBD2 + yo) = w;
        }
    }
    __syncthreads();
}
constexpr int RW_VT = 0, RW_KQ = 9216, RW_RT = 20480, RW_KHT = 29696, RW_AHT = 38912, RW_SA = 48128, RW_SB = 59392, RW_RR = 68608, RW_KR = 77824,
              RW_F0 = 87040, RW_F1 = 100352, RW_SBF = 117760, RW_PAR = 126976, RW_AUPT = 129024, RW_WUPT = 138240, RW_TBT = 147456, RW_END = 153600;
DEV void job_rwkv_chunked(const int sid, const int hd, const int d, const int seg, unsigned char* lds_, int tid, const bf16_t* P, const float* w0, const bf16_t* UPT, const float* a0,
                          const float* k_k, const float* k_a, const float* u, const float* s0, bf16_t* YBD, float* RK, float* out_s, float* SMID, bf16_t* ZB) {
    lbf16* AUPT = (lbf16*)(lds_ + RW_AUPT); lbf16* WUPT = (lbf16*)(lds_ + RW_WUPT); lbf16* VT = (lbf16*)(lds_ + RW_VT);
    lbf16* KQ = (lbf16*)(lds_ + RW_KQ); lbf16* UT = KQ;
    lbf16* RT = (lbf16*)(lds_ + RW_RT); lbf16* KHT = (lbf16*)(lds_ + RW_KHT); lbf16* AHT = (lbf16*)(lds_ + RW_AHT);
    lbf16* SA = (lbf16*)(lds_ + RW_SA);
    lbf16* SB = (lbf16*)(lds_ + RW_SB);
    lbf16* RR = (lbf16*)(lds_ + RW_RR); lbf16* KR = (lbf16*)(lds_ + RW_KR);
    lbf16* aL = (lbf16*)(lds_ + RW_F0); lf32* cumL = (lf32*)(lds_ + RW_F1);
    lbf16* BRA = (lbf16*)(lds_ + RW_F0); lf32* NdL = (lf32*)(lds_ + RW_F0 + 9216);
    lbf16* BRK = (lbf16*)(lds_ + RW_F1);
    lbf16* TBT = (lbf16*)(lds_ + RW_TBT);
    lbf16* SBF = (lbf16*)(lds_ + RW_SBF);
    lf32* par = (lf32*)(lds_ + RW_PAR); lf32* pa0 = par; lf32* pw0 = par + 64; lf32* pkk = par + 128; lf32* pka = par + 192; lf32* pus = par + 256; lf32* invn = par + 320; lf32* lamL = par + 448;
    int row0, T; seq_info(sid, row0, T);
    const int nc = T >> 6, lane = tid & 63, wave = tid >> 6, q4 = (lane >> 4) * 4, l15 = lane & 15;
    const int gc0 = 64 * hd;
    {
        if (tid < 64) { pa0[tid] = a0[gc0 + tid]; pw0[tid] = w0[d * 512 + gc0 + tid]; pkk[tid] = k_k[gc0 + tid]; pka[tid] = k_a[gc0 + tid]; pus[tid] = u[gc0 + tid] + u[512 + gc0 + tid]; }
        for (int i = tid; i < 64 * 88; i += 512) { UT[i] = 0; SA[i] = 0; }
        for (int i = tid; i < 4 * 32 * 24; i += 512) TBT[i] = 0;
        const int j = tid >> 3, c8 = (tid & 7) * 8;
        st16_lds(AUPT + j * 72 + c8, *(const uint4*)(UPT + (size_t)hd * 4096 + j * 64 + c8));
        st16_lds(WUPT + j * 72 + c8, *(const uint4*)(UPT + (size_t)(8 + d * 8 + hd) * 4096 + j * 64 + c8));
    }
    __syncthreads();
    f32x4_t S[2];
    const int s_tv = wave >> 1;
#pragma unroll
    for (int i = 0; i < 2; ++i) {
        const int tk = 2 * (wave & 1) + i;
        if (seg == 3) { for (int r = 0; r < 4; ++r) S[i][r] = (16 * tk + q4 + r == 16 * s_tv + l15) ? 1.f : 0.f; }
        else if (sid >= 32 && seg < 2) S[i] = *(const f32x4_t*)(s0 + ((size_t)((sid - 32) * 2 + d) * 8 + hd) * 4096 + (size_t)(16 * s_tv + l15) * 64 + 16 * tk + q4);
        else S[i] = (f32x4_t){0.f, 0.f, 0.f, 0.f};
    }
    YBD += ((size_t)(d * 8 + hd) * M_ROWS) * 64;
    const int st_lo = seg >= 2 ? (nc >> 1) : 0, st_hi = seg == 1 ? (nc >> 1) : nc;
    uint4 nr, nk, na, nw, nv;
#define RW_LOADP(stp) do { const int j_ = tid >> 3, c8_ = (tid & 7) * 8; const int cidx_ = d ? nc - 1 - (stp) : (stp); \
        const bf16_t* pr_ = P + (size_t)(row0 + 64 * cidx_ + (d ? 63 - j_ : j_)) * PLD + 2064; \
        nr = *(const uint4*)(pr_ + gc0 + c8_); nk = *(const uint4*)(pr_ + 512 + gc0 + c8_); na = *(const uint4*)(pr_ + 1664 + c8_); \
        nw = *(const uint4*)(pr_ + 1536 + 64 * d + c8_); nv = *(const uint4*)(pr_ + 1024 + gc0 + c8_); } while (0)
    RW_LOADP(st_lo);
    for (int step = st_lo; step < st_hi; ++step) {
        const int cidx = d ? nc - 1 - step : step;
        const int rbase = row0 + 64 * cidx;
        {
            const int j = tid >> 3, c8 = (tid & 7) * 8;
            st16_lds(RR + j * 72 + c8, nr);
            st16_lds(KR + j * 72 + c8, nk);
            st16_lds(SB + j * 72 + c8, na);
            float wf[8]; unpack8(nw, wf);
#pragma unroll
            for (int e = 0; e < 8; ++e) { const float x2 = fminf(fmaxf(wf[e], -15.f), 15.f); const float ex = __expf(2.f * x2); wf[e] = (ex - 1.f) * __builtin_amdgcn_rcpf(ex + 1.f); }
            st16_lds(SA + j * 88 + c8, pack8(wf));
            { uint4 vv = nv; if (seg == 3) vv = make_uint4(0u, 0u, 0u, 0u); st16_lds(VT + j * 72 + c8, vv); }
#pragma unroll
            for (int i = 0; i < 2; ++i) st4_bf16(SBF + (16 * s_tv + l15) * 72 + 16 * (2 * (wave & 1) + i) + q4, S[i]);
        }
        __syncthreads();
        {
            const int tt = wave >> 1;
#pragma unroll
            for (int i = 0; i < 2; ++i) {
                const int tc = 2 * (wave & 1) + i;
                f32x4_t za = (f32x4_t){0.f, 0.f, 0.f, 0.f}, zw = za;
                za = mma16<64>(za, AUPT + tc * 16 * 72, 72, SB + tt * 16 * 72, 72, lane);
                zw = mma16<64>(zw, WUPT + tc * 16 * 72, 72, SA + tt * 16 * 88, 88, lane);
                const int t = 16 * tt + l15, c = 16 * tc + q4;
                f32x4_t av, wv;
#pragma unroll
                for (int r = 0; r < 4; ++r) { av[r] = sigmoidf_(pa0[c + r] + za[r]); wv[r] = -0.606531f * sigmoidf_(pw0[c + r] + zw[r]); }
                st4_bf16(aL + t * 72 + c, av);
                *(__attribute__((address_space(3))) f32x4_t*)(cumL + t * 68 + c) = wv;
            }
        }
        __syncthreads();
        if (tid < 256) {
            const int k = tid >> 2, part = tid & 3;
            float v[16]; float run = 0.f;
#pragma unroll
            for (int e = 0; e < 16; ++e) { run += cumL[(part * 16 + e) * 68 + k]; v[e] = run; }
            const float t1 = __shfl_up(run, 1), t2 = __shfl_up(run, 2), t3 = __shfl_up(run, 3);
            const float off = (part >= 1 ? t1 : 0.f) + (part >= 2 ? t2 : 0.f) + (part >= 3 ? t3 : 0.f);
#pragma unroll
            for (int e = 0; e < 16; ++e) cumL[(part * 16 + e) * 68 + k] = __expf(v[e] + off);
            if (part == 3) lamL[k] = __expf(run + off);
        } else {
            const int t = (tid - 256) >> 2, part = tid & 3;
            float ssq = 0.f, rk = 0.f;
#pragma unroll
            for (int e = 0; e < 16; ++e) {
                const int c = part * 16 + e;
                const float kraw = bf2f(KR[t * 72 + c]), a = bf2f(aL[t * 72 + c]);
                const float kkr = kraw * pkk[c];
                ssq += kkr * kkr;
                rk += bf2f(RR[t * 72 + c]) * kraw * (1.f + (a - 1.f) * pka[c]) * pus[c];
            }
            ssq += __shfl_xor(ssq, 1); ssq += __shfl_xor(ssq, 2); rk += __shfl_xor(rk, 1); rk += __shfl_xor(rk, 2);
            if (part == 0) {
                invn[t] = 1.f / fmaxf(sqrtf(ssq), 1e-12f);
                if (d == 0 && seg != 3) RK[(size_t)hd * M_ROWS + rbase + t] = rk;
            }
        }
        __syncthreads();
        {
            const int t = tid >> 3, c8 = (tid & 7) * 8, tm = t > 0 ? t - 1 : 0;
            typedef const __attribute__((address_space(3))) f32x4_t* lv4;
            float kf[8], rf[8], af[8];
            { const u32x4_t kr = *(const __attribute__((address_space(3))) u32x4_t*)(KR + t * 72 + c8); uint4 k4; k4.x = kr.x; k4.y = kr.y; k4.z = kr.z; k4.w = kr.w; unpack8(k4, kf); }
            { const u32x4_t rr = *(const __attribute__((address_space(3))) u32x4_t*)(RR + t * 72 + c8); uint4 r4; r4.x = rr.x; r4.y = rr.y; r4.z = rr.z; r4.w = rr.w; unpack8(r4, rf); }
            { const u32x4_t ar = *(const __attribute__((address_space(3))) u32x4_t*)(aL + t * 72 + c8); uint4 a4; a4.x = ar.x; a4.y = ar.y; a4.z = ar.z; a4.w = ar.w; unpack8(a4, af); }
            const f32x4_t Ev[2] = { *(lv4)(cumL + t * 68 + c8), *(lv4)(cumL + t * 68 + c8 + 4) };
            f32x4_t Pv[2] = { *(lv4)(cumL + tm * 68 + c8), *(lv4)(cumL + tm * 68 + c8 + 4) };
            if (t == 0) { Pv[0] = (f32x4_t){1.f, 1.f, 1.f, 1.f}; Pv[1] = Pv[0]; }
            const f32x4_t Lv[2] = { *(lv4)(lamL + c8), *(lv4)(lamL + c8 + 4) };
            const f32x4_t Kv[2] = { *(lv4)(pkk + c8), *(lv4)(pkk + c8 + 4) };
            const f32x4_t Av[2] = { *(lv4)(pka + c8), *(lv4)(pka + c8 + 4) };
            const float in = invn[t];
            float oq[8], ok[8], oa[8], orr[8], okh[8], oah[8];
#pragma unroll
            for (int e = 0; e < 8; ++e) {
                const float a = af[e], E = Ev[e >> 2][e & 3], em = __builtin_amdgcn_rcpf(E);
                const float kk = kf[e] * Kv[e >> 2][e & 3] * in, ka = kk * a, kb = kf[e] * (1.f + (a - 1.f) * Av[e >> 2][e & 3]);
                oq[e] = kk * Pv[e >> 2][e & 3]; ok[e] = kb * em; oa[e] = ka * em; orr[e] = rf[e] * E;
                const float ee = Lv[e >> 2][e & 3] * em;
                okh[e] = kb * ee; oah[e] = -ka * ee;
            }
            st16_lds(KHT + t * 72 + c8, pack8(okh)); st16_lds(AHT + t * 72 + c8, pack8(oah));
            st16_lds(KQ + t * 88 + c8, pack8(oq)); st16_lds(SA + t * 88 + c8, pack8(ok)); st16_lds(SB + t * 72 + c8, pack8(oa)); st16_lds(RT + t * 72 + c8, pack8(orr));
        }
        __syncthreads();
        {
            const int tt = wave >> 1;
#pragma unroll
            for (int m = 0; m < 4; ++m)
#pragma unroll
                for (int i = 0; i < 2; ++i) {
                    const int ts = 2 * (wave & 1) + i;
                    f32x4_t acc = (f32x4_t){0.f, 0.f, 0.f, 0.f};
                    if (ts <= tt && !(seg == 3 && (m & 1))) {
                        const lbf16* Aop = (m == 0 || m == 2) ? (SB + ts * 16 * 72) : (SA + ts * 16 * 88);
                        const int lda = (m == 0 || m == 2) ? 72 : 88;
                        const lbf16* Bop = (m < 2) ? (KQ + tt * 16 * 88) : (RT + tt * 16 * 72);
                        const int ldb = (m < 2) ? 88 : 72;
                        acc = mma16<64>(acc, Aop, lda, Bop, ldb, lane);
                    }
                    const int t = 16 * tt + l15, sb = 16 * ts + q4;
#pragma unroll
                    for (int r = 0; r < 4; ++r) { const bool keep = (m < 2) ? (sb + r < t) : (sb + r <= t); acc[r] = keep ? acc[r] : 0.f; }
                    if (m == 0) {
                        if (ts == tt) { *(__attribute__((address_space(3))) f32x4_t*)(NdL + (tt * 16 + l15) * 16 + q4) = acc; acc = (f32x4_t){0.f, 0.f, 0.f, 0.f}; }
                        st4_bf16(RR + t * 72 + sb, -acc);
                    } else if (m == 1) st4_bf16(KR + t * 72 + sb, acc);
                    else if (m == 2) st4_bf16(BRA + t * 72 + sb, -acc);
                    else st4_bf16(BRK + t * 72 + sb, acc);
                }
        }
        __syncthreads();
        f32x4_t rhs[2];
        {
            const int tv = wave & 3;
#pragma unroll
            for (int i = 0; i < 2; ++i) {
                const int tt = 2 * (wave >> 2) + i;
                f32x4_t acc = (f32x4_t){0.f, 0.f, 0.f, 0.f};
                acc = mma16<64>(acc, KQ + tt * 16 * 88, 88, SBF + tv * 16 * 72, 72, lane);
                if (seg != 3) acc = mma16_tB<64>(acc, KR + tt * 16 * 72, 72, VT, 72, 16 * tv, lane);
                rhs[i] = acc;
            }
            if (wave == 0) {
                const int b = lane >> 4, j = lane & 15;
                const lf32* N = NdL + b * 256;
                float Tc[16];
                Tc[0] = (j == 0) ? 1.f : 0.f;
#define RW_INV_ROWS(lo, hi) do { f32x4_t Nr_[(hi) - (lo) + 1][4]; \
                    _Pragma("unroll") for (int i_ = (lo); i_ <= (hi); ++i_) _Pragma("unroll") for (int q_ = 0; q_ <= (i_ - 1) >> 2; ++q_) Nr_[i_ - (lo)][q_] = *(const __attribute__((address_space(3))) f32x4_t*)(N + i_ * 16 + 4 * q_); \
                    __builtin_amdgcn_sched_barrier(0); \
                    _Pragma("unroll") for (int i_ = (lo); i_ <= (hi); ++i_) { float acc_ = (i_ == j) ? 1.f : 0.f; \
                        _Pragma("unroll") for (int m_ = 0; m_ < i_; ++m_) acc_ -= Nr_[i_ - (lo)][m_ >> 2][m_ & 3] * Tc[m_]; \
                        Tc[i_] = acc_; } } while (0)
                RW_INV_ROWS(1, 6); RW_INV_ROWS(7, 9); RW_INV_ROWS(10, 11); RW_INV_ROWS(12, 13); RW_INV_ROWS(14, 15);
                float t0[8], t1[8];
#pragma unroll
                for (int i = 0; i < 8; ++i) { t0[i] = Tc[i]; t1[i] = Tc[8 + i]; }
                st16_lds(TBT + (b * 32 + j) * 24, pack8(t0)); st16_lds(TBT + (b * 32 + j) * 24 + 8, pack8(t1));
            }
        }
        __syncthreads();
        { const int nstep = step + 1 < st_hi ? step + 1 : step; RW_LOADP(nstep); }
#pragma unroll
        for (int b = 0; b < 4; ++b) {
            const int tv = wave & 3;
            if ((wave >> 2) == (b >> 1)) {
                f32x4_t x = mma16<64>(rhs[b & 1], RR + b * 16 * 72, 72, UT + tv * 16 * 88, 88, lane);
                st4_bf16(SA + (16 * tv + l15) * 88 + 16 * b + q4, x);
            }
            __syncthreads();
            if ((wave >> 2) == (b >> 1)) {
                f32x4_t ub = (f32x4_t){0.f, 0.f, 0.f, 0.f};
                ub = mma16_tA<32>(ub, TBT + b * 32 * 24, 24, 0, SA + tv * 16 * 88 + 16 * b, 88, lane);
                st4_bf16(UT + (16 * tv + l15) * 88 + 16 * b + q4, ub);
            }
            __syncthreads();
        }
        {
            const int tt = wave >> 1;
#pragma unroll
            for (int i = 0; i < 2; ++i) {
                const int tv = 2 * (wave & 1) + i;
                f32x4_t acc = (f32x4_t){0.f, 0.f, 0.f, 0.f};
                acc = mma16<64>(acc, SBF + tv * 16 * 72, 72, RT + tt * 16 * 72, 72, lane);
                if (seg != 3) acc = mma16_tA<64>(acc, VT, 72, 16 * tv, BRK + tt * 16 * 72, 72, lane);
                acc = mma16<64>(acc, UT + tv * 16 * 88, 88, BRA + tt * 16 * 72, 72, lane);
                const int t = 16 * tt + l15;
                const size_t row = (size_t)(rbase + (d ? 63 - t : t));
                uint2 w; w.x = pg8::cvt_pk_bf16(acc[0], acc[1]); w.y = pg8::cvt_pk_bf16(acc[2], acc[3]);
                if (seg == 3) *(uint2*)(ZB + ((size_t)(d * 8 + hd) * 4096 + zrow_of(sid, d, (int)row)) * 64 + 16 * tv + q4) = w;
                else *(uint2*)(YBD + row * 64 + 16 * tv + q4) = w;
            }
#pragma unroll
            for (int i = 0; i < 2; ++i) {
                const int tk = 2 * (wave & 1) + i;
                f32x4_t acc = S[i];
#pragma unroll
                for (int r = 0; r < 4; ++r) acc[r] *= lamL[16 * tk + q4 + r];
                if (seg != 3) acc = mma16_tAB<64>(acc, KHT, 72, 16 * tk, VT, 72, 16 * s_tv, lane);
                acc = mma16_tA<64>(acc, AHT, 72, 16 * tk, UT + s_tv * 16 * 88, 88, lane);
                S[i] = acc;
            }
        }
        __syncthreads();
    }
    if (seg == 1) {
#pragma unroll
        for (int i = 0; i < 2; ++i) {
            const int tk = 2 * (wave & 1) + i;
            *(f32x4_t*)(SMID + ((size_t)((sid - 32) * 2 + d) * 8 + hd) * 4096 + (size_t)(16 * s_tv + l15) * 64 + 16 * tk + q4) = S[i];
        }
    }
    if (sid < 32) {
#pragma unroll
        for (int i = 0; i < 2; ++i) {
            const int tk = 2 * (wave & 1) + i;
            *(f32x4_t*)(out_s + ((size_t)(sid * 2 + d) * 8 + hd) * 4096 + (size_t)(16 * s_tv + l15) * 64 + 16 * tk + q4) = S[i];
        }
    }
}

constexpr int CB_GL = 0, CB_BT = 17408, CB_G = 17408 + 2 * 17408, CB_END = CB_G + 64 * 520 * 2;
constexpr int CB_FXA = 0, CB_FXB = CB_END, CB_SB = CB_END + 16384, CB_ZC = CB_SB + 9216;
DEV void phase_even_combine_t(const bf16_t* P, const bf16_t* HAD, const bf16_t* HAD2, const bf16_t* YBD, const float* SMID, const bf16_t* ZB, const float* RK, const float* a_norm_w, const bf16_t* GUPT,
                              const float* ln_w, const float* ln_b, bf16_t* Y, unsigned char* lds_, int tid, int blk, int G) {
    lbf16* GLt = (lbf16*)(lds_ + CB_GL); lbf16* Bt = (lbf16*)(lds_ + CB_BT); lbf16* Gl = (lbf16*)(lds_ + CB_G);
    const int lane = tid & 63, wave = tid >> 6, q4 = (lane >> 4) * 4, l15 = lane & 15;
    for (int tile = blk; tile < M_ROWS / 64; tile += G) {
        const int r0 = tile * 64;
        __syncthreads();
        {
            const int j = tid >> 3, c16 = (tid & 7) * 16;
            const bf16_t* src = P + (size_t)(r0 + j) * PLD + 2064 + 1728 + c16;
#pragma unroll
            for (int hh = 0; hh < 2; ++hh) {
                float f[8]; unpack8(*(const uint4*)(src + 8 * hh), f);
#pragma unroll
                for (int e = 0; e < 8; ++e) f[e] = sigmoidf_(f[e]);
                st16_lds(GLt + j * 136 + c16 + 8 * hh, pack8(f));
            }
        }
        for (int cc = 0; cc < 8; ++cc) {
            lbf16* Bc = Bt + (cc & 1) * (64 * 136);
            {
                const int c = tid >> 3, i16 = (tid & 7) * 16;
                const bf16_t* src = GUPT + (size_t)(cc * 64 + c) * 128 + i16;
                st16_lds(Bc + c * 136 + i16, *(const uint4*)src); st16_lds(Bc + c * 136 + i16 + 8, *(const uint4*)(src + 8));
            }
            __syncthreads();
            const int tt = wave >> 1, tc0 = 2 * (wave & 1);
            f32x4_t a0 = (f32x4_t){0.f, 0.f, 0.f, 0.f}, a1 = a0;
            mma16_2A<128>(a0, a1, Bc + tc0 * 16 * 136, Bc + (tc0 + 1) * 16 * 136, 136, GLt + tt * 16 * 136, 136, lane);
            st4_bf16(Gl + (16 * tt + l15) * 520 + cc * 64 + 16 * tc0 + q4, a0);
            st4_bf16(Gl + (16 * tt + l15) * 520 + cc * 64 + 16 * (tc0 + 1) + q4, a1);
        }
        __syncthreads();
        const bool lat_t = r0 >= 8192 && G >= 160;
        lbf16* FXA = (lbf16*)(lds_ + CB_FXA); lbf16* FXB = (lbf16*)(lds_ + CB_FXB);
        if (lat_t) {
            lbf16* Sb = (lbf16*)(lds_ + CB_SB); lbf16* Zc = (lbf16*)(lds_ + CB_ZC);
            const int sq = (r0 - 8192) >> 12, dd = ((((r0 - 8192) & 4095) >> 6) >= 32) ? 0 : 1;
            const int j = tid >> 3, c8 = (tid & 7) * 8;
            const size_t zoff = ((size_t)(dd * 8) * 4096 + zrow_of(32 + sq, dd, r0 + j)) * 64 + c8;
            const float* sp0 = SMID + ((size_t)(sq * 2 + dd) * 8) * 4096 + j * 64 + c8;
            float4 sa = *(const float4*)sp0, sb4 = *(const float4*)(sp0 + 4); uint4 zq = *(const uint4*)(ZB + zoff);
            for (int hd = 0; hd < 8; ++hd) {
                { float f[8] = {sa.x, sa.y, sa.z, sa.w, sb4.x, sb4.y, sb4.z, sb4.w}; st16_lds(Sb + j * 72 + c8, pack8(f)); st16_lds(Zc + j * 72 + c8, zq); }
                __syncthreads();
                { const int hn = hd < 7 ? hd + 1 : hd; const float* sp = sp0 + (size_t)hn * 4096; sa = *(const float4*)sp; sb4 = *(const float4*)(sp + 4); zq = *(const uint4*)(ZB + zoff + (size_t)hn * 4096 * 64); }
                const int tt = wave >> 1;
#pragma unroll
                for (int i = 0; i < 2; ++i) {
                    const int tv = 2 * (wave & 1) + i;
                    f32x4_t acc = (f32x4_t){0.f, 0.f, 0.f, 0.f};
                    acc = mma16<64>(acc, Sb + tv * 16 * 72, 72, Zc + tt * 16 * 72, 72, lane);
                    lbf16* dst = hd < 6 ? FXA + (16 * tt + l15) * 384 + hd * 64 + 16 * tv + q4 : FXB + (16 * tt + l15) * 128 + (hd - 6) * 64 + 16 * tv + q4;
                    st4_bf16(dst, acc);
                }
                __syncthreads();
            }
        }
        for (int rr = 0; rr < 8; ++rr) {
            const int tl = wave * 8 + rr;
            const size_t r = (size_t)(r0 + tl);
            const int c0 = lane * 8;
            {
                float x[8]; float sacc = 0.f;
                {
                    const int hh = c0 >> 7, cc = c0 & 127, vq = cc >> 5, c5 = cc & 31;
                    float f0[8], f1[8];
                    unpack8(*(const uint4*)(had_slab(HAD, HAD2, (0 * 4 + vq) * 4 + hh) + r * 32 + c5), f0);
                    unpack8(*(const uint4*)(had_slab(HAD, HAD2, (1 * 4 + vq) * 4 + hh) + r * 32 + c5), f1);
#pragma unroll
                    for (int e = 0; e < 8; ++e) { x[e] = f0[e] + f1[e]; sacc += x[e]; }
                }
#pragma unroll
                for (int o = 1; o < 16; o <<= 1) sacc += __shfl_xor(sacc, o);
                const float mean = sacc * (1.f / 128.f);
                float q = 0.f;
#pragma unroll
                for (int e = 0; e < 8; ++e) { x[e] -= mean; q += x[e] * x[e]; }
#pragma unroll
                for (int o = 1; o < 16; o <<= 1) q += __shfl_xor(q, o);
                const float rs = rsqrtf(q * (1.f / 128.f) + 1e-6f);
                float ao[8]; unpack8(*(const uint4*)(P + r * PLD + 1536 + c0), ao);
                float y[8];
#pragma unroll
                for (int e = 0; e < 8; ++e) y[e] = x[e] * rs * a_norm_w[c0 + e] * sigmoidf_(ao[e]);
                *(uint4*)(Y + r * 1024 + c0) = pack8(y);
            }
            {
                float x[8]; float sacc = 0.f;
                const int hd = c0 >> 6, c6 = c0 & 63;
                {
                    float f0[8], f1[8];
                    unpack8(*(const uint4*)(YBD + ((size_t)(0 * 8 + hd) * M_ROWS + r) * 64 + c6), f0);
                    unpack8(*(const uint4*)(YBD + ((size_t)(1 * 8 + hd) * M_ROWS + r) * 64 + c6), f1);
                    if (lat_t) {
                        float fx[8]; const lbf16* fp = hd < 6 ? FXA + tl * 384 + c0 : FXB + tl * 128 + (c0 - 384);
                        { const u32x4_t fr4 = *(const __attribute__((address_space(3))) u32x4_t*)fp; uint4 f4; f4.x = fr4.x; f4.y = fr4.y; f4.z = fr4.z; f4.w = fr4.w; unpack8(f4, fx); }
#pragma unroll
                        for (int e = 0; e < 8; ++e) f0[e] += fx[e];
                    }
#pragma unroll
                    for (int e = 0; e < 8; ++e) { x[e] = f0[e] + f1[e]; sacc += x[e]; }
                }
#pragma unroll
                for (int o = 1; o < 8; o <<= 1) sacc += __shfl_xor(sacc, o);
                const float mean = sacc * (1.f / 64.f);
                float q = 0.f;
#pragma unroll
                for (int e = 0; e < 8; ++e) { x[e] -= mean; q += x[e] * x[e]; }
#pragma unroll
                for (int o = 1; o < 8; o <<= 1) q += __shfl_xor(q, o);
                const float rs = rsqrtf(q * (1.f / 64.f) + 64e-5f);
                float g[8];
                { const u32x4_t gr = *(const __attribute__((address_space(3))) u32x4_t*)(Gl + tl * 520 + c0); uint4 g4; g4.x = gr.x; g4.y = gr.y; g4.z = gr.z; g4.w = gr.w; unpack8(g4, g); }
                float vb[8]; unpack8(*(const uint4*)(P + r * PLD + 2064 + 1024 + c0), vb);
                const float rk = RK[(size_t)hd * M_ROWS + r];
                float y[8];
#pragma unroll
                for (int e = 0; e < 8; ++e) y[e] = (x[e] * rs * ln_w[c0 + e] + ln_b[c0 + e] + rk * vb[e]) * g[e];
                *(uint4*)(Y + r * 1024 + 512 + c0) = pack8(y);
            }
        }
    }
}

#define LAS __attribute__((address_space(3)))
#define XB_TMO      128
#define XB_XCNT(j)  (256  + 64 * (j))
#define XB_XSUB(j)  (1280 + 64 * (j))
#define XB_XGEN(j)  (2304 + 64 * (j))
#define XB_TOP      3328
#define XB_TOPGEN   3392
#define XCD_BAR_WORDS 3456
#define XB_SPIN_CAP (1u << 25)
__device__ __forceinline__ unsigned xb_ld(unsigned* p)              { return __hip_atomic_load(p, __ATOMIC_RELAXED, __HIP_MEMORY_SCOPE_AGENT); }
__device__ __forceinline__ unsigned xb_add(unsigned* p, unsigned v) { return __hip_atomic_fetch_add(p, v, __ATOMIC_RELAXED, __HIP_MEMORY_SCOPE_AGENT); }
__device__ __forceinline__ unsigned xb_xcc_id() { return (unsigned)__builtin_amdgcn_s_getreg((3 << 11) | 20) & 0xFu; }
#define XB_SPIN(cond, bar) do { unsigned _sp = 0; while (cond) { __builtin_amdgcn_s_sleep(1); \
    if ((++_sp & 255u) == 0u) { if (xb_ld(&(bar)[XB_TMO])) break; if (_sp > XB_SPIN_CAP) { atomicAdd(&(bar)[XB_TMO], 1u); break; } } } } while (0)
struct XcdBarrier { unsigned* bar; unsigned x; volatile LAS unsigned* st; };
__device__ __forceinline__ XcdBarrier xcd_barrier_post(unsigned* bar, volatile LAS unsigned* st) {
    XcdBarrier b; b.bar = bar; b.x = xb_xcc_id(); b.st = st;
    if (threadIdx.x == 0) (void)xb_add(&bar[XB_XCNT(b.x)], 1u);
    return b;
}
__device__ __forceinline__ void xcd_barrier_complete(unsigned* bar, unsigned x, unsigned& nloc, unsigned& nx) {
    const unsigned G = gridDim.x * gridDim.y * gridDim.z;
    unsigned sum, cnt, mine, sp = 0u;
    for (;;) {
        sum = 0u; cnt = 0u; mine = 0u;
#pragma unroll
        for (unsigned j = 0; j < 16; ++j) { const unsigned c = xb_ld(&bar[XB_XCNT(j)]); sum += c; cnt += (c > 0u) ? 1u : 0u; mine = (j == x) ? c : mine; }
        if (sum == G) break;
        __builtin_amdgcn_s_sleep(1);
        if ((++sp & 255u) == 0u) { if (xb_ld(&bar[XB_TMO])) break; if (sp > XB_SPIN_CAP) { atomicAdd(&bar[XB_TMO], 1u); break; } }
    }
    nloc = mine > 0u ? mine : 1u; nx = cnt > 0u ? cnt : 1u;
}
__device__ __forceinline__ void xcd_barrier(const XcdBarrier& b) {
    asm volatile("s_waitcnt vmcnt(0)" ::: "memory");
    __syncthreads();
    if (threadIdx.x == 0) {
        unsigned* bar = b.bar;
        __builtin_amdgcn_s_waitcnt(0);
        unsigned nloc = b.st[0], nx = b.st[1];
        if (nloc == 0u) { xcd_barrier_complete(bar, b.x, nloc, nx); b.st[0] = nloc; b.st[1] = nx; }
        const unsigned old = xb_add(&bar[XB_XSUB(b.x)], 1u);
        const unsigned gen = old / nloc;
        if (old + 1u == (gen + 1u) * nloc) {
            __builtin_amdgcn_fence(__ATOMIC_RELEASE, "agent");
            asm volatile("s_waitcnt vmcnt(0)" ::: "memory");
            const unsigned og = xb_add(&bar[XB_TOP], 1u);
            const unsigned tg = og / nx;
            if (og + 1u == (tg + 1u) * nx) xb_add(&bar[XB_TOPGEN], 1u);
            else XB_SPIN(xb_ld(&bar[XB_TOPGEN]) == tg, bar);
            __builtin_amdgcn_fence(__ATOMIC_ACQUIRE, "agent");
            asm volatile("s_waitcnt vmcnt(0)" ::: "memory");
        } else {
            XB_SPIN(xb_ld(&bar[XB_TOPGEN]) == gen, bar);
            __builtin_amdgcn_fence(__ATOMIC_ACQUIRE, "agent");
            asm volatile("s_waitcnt vmcnt(0)" ::: "memory");
        }
    }
    __syncthreads();
}

constexpr int LDS_BYTES = 163840;
constexpr int LDS_MISC = 163328;
struct MegaArgs { const float* in[40]; float* out; unsigned char* ws; ConvArgs ca, cb, cc, cd, ce; };

#define XB2_XSUB(s, j) (3456 + 32 * (s) + (j))
#define XB2_TOP(s)     (3456 + 32 * (s) + 16)
#define XB2_TOPGEN(s)  (3456 + 32 * (s) + 17)
__device__ __forceinline__ void xcd_split_arrive(const XcdBarrier& b, int s) {
    asm volatile("s_waitcnt vmcnt(0)" ::: "memory");
    __syncthreads();
    if (threadIdx.x == 0) {
        unsigned* bar = b.bar;
        __builtin_amdgcn_s_waitcnt(0);
        unsigned nloc = b.st[0], nx = b.st[1];
        if (nloc == 0u) { xcd_barrier_complete(bar, b.x, nloc, nx); b.st[0] = nloc; b.st[1] = nx; }
        const unsigned old = xb_add(&bar[XB2_XSUB(s, b.x)], 1u);
        if (old + 1u == nloc) {
            __builtin_amdgcn_fence(__ATOMIC_RELEASE, "agent");
            asm volatile("s_waitcnt vmcnt(0)" ::: "memory");
            const unsigned og = xb_add(&bar[XB2_TOP(s)], 1u);
            if (og + 1u == nx) (void)xb_add(&bar[XB2_TOPGEN(s)], 1u);
        }
    }
}
__device__ __forceinline__ void xcd_split_wait(const XcdBarrier& b, int s) {
    if (threadIdx.x == 0) {
        XB_SPIN(xb_ld(&b.bar[XB2_TOPGEN(s)]) == 0u, b.bar);
        __builtin_amdgcn_fence(__ATOMIC_ACQUIRE, "agent");
        asm volatile("s_waitcnt vmcnt(0)" ::: "memory");
    }
    __syncthreads();
}
__global__ void __launch_bounds__(512, 2) mega_fwd(MegaArgs a) {
    extern __shared__ __attribute__((aligned(16))) unsigned char lds[];
    const int G = (int)gridDim.x, blk = (int)blockIdx.x, ngw = G * 8;
    if (G != 256) { if (threadIdx.x == 0) a.out[(size_t)blk * 1024] = __builtin_nanf(""); return; }
#define TIDX() int tid = threadIdx.x; asm volatile("" : "+v"(tid)); const int lane = tid & 63, wave = __builtin_amdgcn_readfirstlane(tid >> 6), gw = blk * 8 + wave; (void)lane; (void)gw
    { TIDX(); for (int u = tid; u < (LDS_BYTES - LDS_MISC) / 4; u += 512) ((unsigned*)(lds + LDS_MISC))[u] = 0u; }
    __syncthreads();
    unsigned char* ws = a.ws;
    const size_t MiB = 1u << 20;
    XcdBarrier bar = xcd_barrier_post((unsigned*)ws, (volatile LAS unsigned*)(lds + LDS_MISC));
#define GRID_BAR() xcd_barrier(bar)
#define PANEL_WAIT(ctr) do { if (threadIdx.x == 0) { unsigned* c_ = (ctr) + (8 * (blk & 7) + ((blk >> 3) & 7));     \
        XB_SPIN(xb_ld(c_) < 4u, bar.bar); __builtin_amdgcn_fence(__ATOMIC_ACQUIRE, "agent"); asm volatile("s_waitcnt vmcnt(0)" ::: "memory"); } __syncthreads(); } while (0)

    const float* x_prompt = a.in[0]; const float* x_sample = a.in[1];
    const float* st_c = a.in[2]; const float* st_n = a.in[3]; const float* st_m = a.in[4]; const float* st_rwkv = a.in[5]; const float* st_ssd = a.in[6];
    const float* c = a.in[7]; const float* c_ctx = a.in[8]; const float* mod_w = a.in[9]; const float* mod_b = a.in[10]; const float* norm_w = a.in[11];
    const float* ev_a_conv_w = a.in[15]; const float* ev_a_conv_b = a.in[16]; const float* ev_a_gate_b = a.in[17]; const float* ev_a_norm_w = a.in[18];
    const float* ev_b_mu = a.in[19]; const float* ev_b_w0 = a.in[20]; const float* ev_b_w_up = a.in[21]; const float* ev_b_a0 = a.in[22]; const float* ev_b_a_up = a.in[23];
    const float* ev_b_g_up = a.in[24]; const float* ev_b_k_k = a.in[25]; const float* ev_b_k_a = a.in[26]; const float* ev_b_u = a.in[27];
    const float* ev_b_ln_w = a.in[28]; const float* ev_b_ln_b = a.in[29];
    const float* od_conv_w = a.in[32]; const float* od_conv_b = a.in[33]; const float* od_dt_bias = a.in[34]; const float* od_a_log = a.in[35]; const float* od_d = a.in[36];
    const float* final_norm_w = a.in[39];

    float* out = a.out;
    float* OUT = out;
    bf16_t* XB = (bf16_t*)(ws + 10 * MiB);
    float* o_mc = out + 16777216; float* o_mn = o_mc + 4194304; float* o_mm = o_mn + 32768; float* o_rw = o_mm + 256; float* o_ssd = o_rw + 2097152;
    unsigned char* wa = (unsigned char*)o_ssd;
    bf16_t* Wev_in = (bf16_t*)(wa); bf16_t* Wev_out = (bf16_t*)(wa + 8 * MiB); bf16_t* Wffn_in0 = (bf16_t*)(wa + 10 * MiB);
    bf16_t* Wffn_out0 = (bf16_t*)(wa + 21 * MiB); bf16_t* Wod_xbc = (bf16_t*)(wa + 27 * MiB);
    float* MODS = (float*)(ws + 1 * MiB); float* ROWSS = (float*)(ws + 1 * MiB + 512 * 1024); bf16_t* GUPT = (bf16_t*)(ws + 254 * MiB + 512 * 1024); bf16_t* UPT = (bf16_t*)(ws + 1 * MiB + 768 * 1024);
    float* TPOS = (float*)(ws + 246 * MiB); float* RS4 = (float*)(ws + 255 * MiB); unsigned* NCNT = (unsigned*)ws + 3584; unsigned* PDONE = (unsigned*)ws + 3904; unsigned* TMOW = (unsigned*)ws + XB_TMO; bf16_t* HB = (bf16_t*)(ws + 202 * MiB); bf16_t* YS2 = (bf16_t*)(a.out + 8388608); bf16_t* YBD2 = (bf16_t*)(a.out + 8388608);
    bf16_t* Wod_z = (bf16_t*)(ws + 2 * MiB); float* SIDE = (float*)(ws + 6 * MiB); bf16_t* H = (bf16_t*)out;
    bf16_t* P = (bf16_t*)(ws + 42 * MiB); bf16_t* Yev = (bf16_t*)(ws + 170 * MiB); bf16_t* HAD = (bf16_t*)(wa + 36 * MiB); bf16_t* HAD2 = (bf16_t*)(ws + 235 * MiB); bf16_t* YBD = (bf16_t*)(ws + 202 * MiB); float* RK = (float*)(ws + 234 * MiB); float* SMID = (float*)(ws + 234 * MiB + 524288); bf16_t* ZB = (bf16_t*)(ws + 240 * MiB);
    bf16_t* ACT0 = (bf16_t*)(ws + 42 * MiB);
    bf16_t* P2a = (bf16_t*)(ws + 42 * MiB); bf16_t* YS = (bf16_t*)(ws + 178 * MiB); float* HALO2 = (float*)(ws + 250 * MiB);     bf16_t* Y2 = (bf16_t*)(ws + 64 * MiB);
    bf16_t* Wod_out = (bf16_t*)(ws + 242 * MiB); bf16_t* Wffn_in1 = (bf16_t*)(ws + 46 * MiB); bf16_t* Wffn_out1 = (bf16_t*)(ws + 246 * MiB); bf16_t* ACT1 = (bf16_t*)(ws + 128 * MiB);
    const float* mods0 = MODS; const float* mods1 = MODS + 3 * 6144;
    PG8_LAS unsigned char* glds = (PG8_LAS unsigned char*)lds;

    { TIDX();
    phase_mods(c, c_ctx, mod_w, mod_b, MODS, lds, tid, blk, G);
    for (int i = blk * 512 + tid; i < M_ROWS; i += G * 512) { ROWSS[i] = 0.f; RS4[i] = 0.f; RS4[M_ROWS + i] = 0.f; RS4[2 * M_ROWS + i] = 0.f; RS4[3 * M_ROWS + i] = 0.f; }
    for (int i = blk * 512 + tid; i < 64 * 512; i += G * 512) {
        const int pos = i >> 9, jj = i & 511, ii = jj & 255;
        const float arg = (float)pos * expf(-9.210340371976184f * (float)ii / 256.f);
        TPOS[i] = (jj & 256) ? cosf(arg) : sinf(arg);
    }
    for (int i = blk * 512 + tid; i < 512 * 128; i += G * 512) GUPT[i] = f2bf(ev_b_g_up[(size_t)(i & 127) * 512 + (i >> 7)]);
    for (int i = blk * 512 + tid; i < 24 * 4096; i += G * 512) {
        const int tb = i >> 12, cc = (i >> 6) & 63, ii = i & 63;
        const float wv = tb < 8 ? ev_b_a_up[(size_t)ii * 512 + 64 * tb + cc] : ev_b_w_up[(size_t)(((tb - 8) >> 3) * 64 + ii) * 512 + 64 * ((tb - 8) & 7) + cc];
        UPT[i] = f2bf(wv);
    }
    xcd_split_arrive(bar, 0);
    conv_all(a.ca, (float*)lds + wave * (64 * 33), gw, ngw, lane);
    xcd_split_wait(bar, 0); }
    { TIDX(); phase_embed_norm(x_prompt, x_sample, TPOS, XB, norm_w + 0, mods0, 0, 1, H, gw, ngw, lane); }
    GRID_BAR();
    { TIDX(); stage_mix_weights(lds, 4096, 0, 1024, ev_a_conv_w, ev_a_conv_b, 2064, 1856, ev_b_mu, tid, blk, G); }
    { pg8::StaticOrder S; S.init(M_ROWS, 4096, G, blk);
      pg8::gemm_phase<pg8::EpiProjMix, pg8::StaticOrder, true, true>(glds, pg8::Gemm{H, Wev_in, M_ROWS, 4096, 1024}, S,
          pg8::EpiProjMix{P, PLD, SIDE, 2048, 16, HALO2, 0, 1024, ev_a_conv_w, ev_a_conv_b, 2064, 1856, ev_b_mu, (PG8_LAS float*)(glds + pg8::STAGE_BYTES)}); }
    GRID_BAR();
    { TIDX(); phase_mix_edges(P, PLD, HALO2, 0, 1024, ev_a_conv_w, ev_a_conv_b, 2064, 1856, ev_b_mu, tid, blk, G); }
    GRID_BAR();
    {
        unsigned* qctr = (unsigned*)(ws + 15360);
        volatile unsigned* qslot = (volatile unsigned*)(lds + LDS_MISC + 64);
        if (G >= 160) {
            if (blk < 96) {
                TIDX(); const int seg = 1 + blk / 32, idx = blk & 31, rem = idx & 15;
                job_rwkv_chunked(32 + (idx >> 4), rem >> 1, rem & 1, seg, lds, tid, P, ev_b_w0, UPT, ev_b_a0, ev_b_k_k, ev_b_k_a, ev_b_u, st_rwkv, YBD, RK, o_rw, SMID, ZB);
            } else if (blk < 160) {
                TIDX(); const int j = blk - 96, rem = j & 31;
                job_mlstm_chunked<1>(32 + (j >> 5), rem >> 3, (rem >> 1) & 3, rem & 1, lds, tid, P, SIDE, ev_a_gate_b, st_c, st_n, st_m, HAD, HAD2, o_mc, o_mn, o_mm);
            }
        }
        const int nlat = (G >= 160) ? 0 : 96;
        for (;;) {
            __syncthreads();
            if (threadIdx.x == 0) *qslot = atomicAdd(qctr, 1u);
            __syncthreads();
            const int q = (int)*qslot;
            if (q >= 1024 + nlat) break;
            TIDX();
            if (q < nlat) {
                if (q < 32) { const int rem = q & 15; job_rwkv_chunked(32 + (q >> 4), rem >> 1, rem & 1, 0, lds, tid, P, ev_b_w0, UPT, ev_b_a0, ev_b_k_k, ev_b_k_a, ev_b_u, st_rwkv, YBD, RK, o_rw, SMID, ZB); }
                else { const int j = q - 32, rem = j & 31; job_mlstm_chunked<1>(32 + (j >> 5), rem >> 3, (rem >> 1) & 3, rem & 1, lds, tid, P, SIDE, ev_a_gate_b, st_c, st_n, st_m, HAD, HAD2, o_mc, o_mn, o_mm); }
            } else {
                const int p = q - nlat;
                if (p < 512) { const int rem = p & 15; job_rwkv_chunked(p >> 4, rem >> 1, rem & 1, 0, lds, tid, P, ev_b_w0, UPT, ev_b_a0, ev_b_k_k, ev_b_k_a, ev_b_u, st_rwkv, YBD, RK, o_rw, SMID, ZB); }
                else { const int jj = p - 512, rem = jj & 15; job_mlstm_chunked<2>(jj >> 4, rem >> 2, (rem >> 1) & 1, rem & 1, lds, tid, P, SIDE, ev_a_gate_b, st_c, st_n, st_m, HAD, HAD2, o_mc, o_mn, o_mm); }
            }
        }
    }
    GRID_BAR();
    { TIDX(); phase_even_combine_t(P, HAD, HAD2, YBD, SMID, ZB, RK, ev_a_norm_w, GUPT, ev_b_ln_w, ev_b_ln_b, Yev, lds, tid, blk, G);
      __syncthreads();
      if (blk < 128) conv_all(a.cc, (float*)lds + wave * (64 * 33), blk * 8 + wave, 128 * 8, lane); }
    GRID_BAR();
    { pg8::StaticOrder S; S.init(M_ROWS, 1024, G, blk);
      pg8::gemm_phase<pg8::EpiResidNorm, pg8::StaticOrder, true, true>(glds, pg8::Gemm{Yev, Wev_out, M_ROWS, 1024, 1024}, S,
          pg8::EpiResidNorm{XB, OUT, mods0 + 2 * 1024, nullptr, 0.f, RS4, NCNT, TMOW, norm_w + 1024, mods0, 3, 4, HB, PDONE}); }
    PANEL_WAIT(PDONE);
    { pg8::StaticOrder S; S.init(M_ROWS, 2 * FFN_H, G, blk);
      pg8::gemm_phase<pg8::EpiSwiGLU, pg8::StaticOrder, true, true>(glds, pg8::Gemm{HB, Wffn_in0, M_ROWS, 2 * FFN_H, 1024}, S, pg8::EpiSwiGLU{ACT0, FFN_H}); }
    if (blk >= 128) { TIDX(); conv_all(a.cd, (float*)lds + wave * (64 * 33), (blk - 128) * 8 + wave, 128 * 8, lane); }
    GRID_BAR();
    { pg8::StaticOrder S; S.init(M_ROWS, 1024, G, blk);
      pg8::gemm_phase<pg8::EpiResidNorm, pg8::StaticOrder, true, true>(glds, pg8::Gemm{ACT0, Wffn_out0, M_ROWS, 1024, FFN_H}, S,
          pg8::EpiResidNorm{XB, OUT, mods0 + 5 * 1024, nullptr, 0.f, RS4 + M_ROWS, NCNT + 64, TMOW, norm_w + 2048, mods1, 0, 1, H, nullptr}); }
    GRID_BAR();
    { TIDX(); stage_mix_weights(lds, 4096, 0, 4096, od_conv_w, od_conv_b, 0, 0, od_conv_w, tid, blk, G); }
    { pg8::StaticOrder S; S.init(M_ROWS, 4096, G, blk);
      pg8::gemm_phase<pg8::EpiProjMix, pg8::StaticOrder, true, true>(glds, pg8::Gemm{H, Wod_xbc, M_ROWS, 4096, 1024}, S,
          pg8::EpiProjMix{P2a, P2LD, nullptr, 0, 0, HALO2, 0, 4096, od_conv_w, od_conv_b, 0, 0, od_conv_w, (PG8_LAS float*)(glds + pg8::STAGE_BYTES)}); }
    xcd_split_arrive(bar, 1);
    { TIDX(); phase_dt(H, Wod_xbc + (size_t)4096 * 1024, SIDE, lds, tid, blk, G);
      xcd_split_wait(bar, 1);
      phase_mix_edges(P2a, P2LD, HALO2, 0, 4096, od_conv_w, od_conv_b, 0, 0, od_conv_w, tid, blk, G); }
    GRID_BAR();
    {
        TIDX();
        if (G == 256) {
            if (blk < 128) {
                const int x = blk & 7, slot = blk >> 3, set = x * 4 + (slot >> 2), member = slot & 3, dd = set & 1;
                job_ssd_1dir(32 + (set >> 4), ((set >> 1) & 7) * 4 + member, dd, lds, tid, P2a, SIDE, od_dt_bias, od_a_log, od_d, st_ssd, dd ? YS2 : YS, dd ? 8192 : M_ROWS, dd ? 8192 : 0);
                __syncthreads();
            } else {
                const int b2 = blk - 128, x = b2 & 7, slot = b2 >> 3, member = slot & 3;
                for (int k = 0; k < 8; ++k) {
                    const int sg = k * 32 + x * 4 + (slot >> 2);
                    job_ssd_chunked<2>(sg >> 3, (sg & 7) * 4 + member, 0, lds, tid, P2a, SIDE, od_dt_bias, od_a_log, od_d, st_ssd, YS, o_ssd);
                    __syncthreads();
                }
            }
        } else {
            for (int j = blk; j < 2176; j += G) {
                const int jj = j < 128 ? j : j - 128;
                job_ssd_chunked<1>(j < 128 ? 32 + (jj >> 6) : (jj >> 6), (jj >> 1) & 31, jj & 1, lds, tid, P2a, SIDE, od_dt_bias, od_a_log, od_d, st_ssd, YS, o_ssd);
                __syncthreads();
            }
        }
    }
    xcd_split_arrive(bar, 2);
    { pg8::StaticOrder S; S.init(M_ROWS, 2048, G, blk);
      pg8::gemm_phase<pg8::EpiGateZ, pg8::StaticOrder, true, true>(glds, pg8::Gemm{H, Wod_z, M_ROWS, 2048, 1024}, S, pg8::EpiGateZ{YS, Y2, 2048, ROWSS, bar.bar + XB2_TOPGEN(2), bar.bar + XB_TMO, YS2}); }
    { TIDX(); conv_all(a.cb, (float*)lds + wave * (64 * 33), gw, ngw, lane); }
    GRID_BAR();
    { pg8::StaticOrder S; S.init(M_ROWS, 1024, G, blk);
      pg8::gemm_phase<pg8::EpiResidNorm, pg8::StaticOrder, true, true>(glds, pg8::Gemm{Y2, Wod_out, M_ROWS, 1024, 2048}, S,
          pg8::EpiResidNorm{XB, OUT, mods1 + 2 * 1024, ROWSS, 1.f / 2048.f, RS4 + 2 * M_ROWS, NCNT + 128, TMOW, norm_w + 3072, mods1, 3, 4, H, PDONE + 64}); }
    PANEL_WAIT(PDONE + 64);
    { pg8::StaticOrder S; S.init(M_ROWS, 2 * FFN_H, G, blk);
      pg8::gemm_phase<pg8::EpiSwiGLU, pg8::StaticOrder, true, true>(glds, pg8::Gemm{H, Wffn_in1, M_ROWS, 2 * FFN_H, 1024}, S, pg8::EpiSwiGLU{ACT1, FFN_H}); }
    if (blk >= 128) { TIDX(); conv_all(a.ce, (float*)lds + wave * (64 * 33), (blk - 128) * 8 + wave, 128 * 8, lane); }
    GRID_BAR();
    { pg8::StaticOrder S; S.init(M_ROWS, 1024, G, blk);
      pg8::gemm_phase<pg8::EpiResidNorm, pg8::StaticOrder, true, true>(glds, pg8::Gemm{ACT1, Wffn_out1, M_ROWS, 1024, FFN_H}, S,
          pg8::EpiResidNorm{XB, OUT, mods1 + 5 * 1024, nullptr, 0.f, RS4 + 3 * M_ROWS, NCNT + 192, TMOW, final_norm_w, nullptr, 0, 0, nullptr, nullptr}); }
}

static void add_conv(ConvArgs& a, const float* W, const float* kscale, bf16_t* WT, int ldw, int K, int Ndst, int mode, int c0, int nvalid) {
    ConvJob& j = a.j[a.njobs++];
    j.W = W; j.kscale = kscale; j.WT = WT; j.ldw = ldw; j.K = K; j.Ndst = Ndst; j.mode = mode; j.c0 = c0; j.nvalid = nvalid;
    j.item0 = a.total; j.nitems = (K / 64) * (Ndst / 32); a.total += j.nitems;
}

extern "C" void kernel_launch(void* const* d_in, const int* in_sizes, int n_in, void* d_out, int out_size, void* d_ws, size_t ws_size, hipStream_t stream) {
    static int grid = 0;
    if (grid == 0) {
        int dev = 0, cus = 0;
        if (hipGetDevice(&dev) != hipSuccess || hipDeviceGetAttribute(&cus, hipDeviceAttributeMultiprocessorCount, dev) != hipSuccess) cus = 256;
        (void)hipFuncSetAttribute((const void*)mega_fwd, hipFuncAttributeMaxDynamicSharedMemorySize, LDS_BYTES);
        (void)hipGetLastError();
        grid = (cus <= 0 || cus >= 256) ? 256 : cus;
    }
    MegaArgs a{};
    for (int i = 0; i < 40; ++i) a.in[i] = (const float*)d_in[i];
    a.out = (float*)d_out; a.ws = (unsigned char*)d_ws;
    const float* ffn_w_in = a.in[12]; const float* ffn_w_out = a.in[13]; const float* ev_w_in = a.in[14]; const float* ev_w_out = a.in[30];
    const float* od_w_in = a.in[31]; const float* od_norm_w = a.in[37]; const float* od_w_out = a.in[38];
    unsigned char* ws = (unsigned char*)d_ws;
    const size_t MiB = 1u << 20;
    unsigned char* wa = (unsigned char*)((float*)d_out + 23101696);
    add_conv(a.ca, ev_w_in, nullptr, (bf16_t*)(wa), 3920, 1024, 4096, 0, 0, 3920);
    add_conv(a.ca, ev_w_out, nullptr, (bf16_t*)(wa + 8 * MiB), 1024, 1024, 1024, 0, 0, 1024);
    add_conv(a.cc, ffn_w_in, nullptr, (bf16_t*)(wa + 10 * MiB), 5632, 1024, 5632, 1, 0, 5632);
    add_conv(a.cd, ffn_w_out, nullptr, (bf16_t*)(wa + 21 * MiB), 1024, 2816, 1024, 0, 0, 1024);
    add_conv(a.cd, od_w_in, nullptr, (bf16_t*)(wa + 27 * MiB), 6208, 1024, 4352, 0, 2048, 4160);
    add_conv(a.cd, od_w_in, nullptr, (bf16_t*)(ws + 2 * MiB), 6208, 1024, 2048, 0, 0, 2048);
    add_conv(a.cd, od_w_out, od_norm_w, (bf16_t*)(ws + 242 * MiB), 1024, 2048, 1024, 0, 0, 1024);
    add_conv(a.cb, ffn_w_in + (size_t)1024 * 2 * FFN_H, nullptr, (bf16_t*)(ws + 46 * MiB), 5632, 1024, 5632, 1, 0, 5632);
    add_conv(a.ce, ffn_w_out + (size_t)FFN_H * 1024, nullptr, (bf16_t*)(ws + 246 * MiB), 1024, 2816, 1024, 0, 0, 1024);
    (void)hipMemsetAsync(d_ws, 0, 16384, stream);
    hipLaunchKernelGGL(mega_fwd, dim3(grid), dim3(512), LDS_BYTES, stream, a);
}
```
